# Optimizing an MI355X kernel written in HIP

```python
import jax, jax.numpy as jnp
from jax import lax
import numpy as np

D_MODEL = 2048
BATCH = 2
SEQ = 4096
DEPTH = 4

HEAD_DIM = 64
D_MIX = D_MODEL
GMLP_WIDTH = D_MIX // 4
ATTN_WIDTH = D_MIX // 2
FNET_WIDTH = D_MIX // 4
GMLP_HEADS = GMLP_WIDTH // HEAD_DIM
ATTN_HEADS = ATTN_WIDTH // HEAD_DIM
FNET_GROUPS = FNET_WIDTH // HEAD_DIM
CHUNK = 128
Q_BLOCK = 128
DILATED_PATTERNS = ((128, 1), (512, 4), (2048, 16))
REL_BUCKETS = 32
REL_MAX_DISTANCE = 1024
D_FF = 5632
CONV_WIDTH = 3
EPS = 1e-6
IN_WIDTH = 2 * GMLP_WIDTH + 3 * ATTN_WIDTH + FNET_WIDTH

kernel_name = "hybrid_gmlp_dilated_fnet_encoder"


def _rms_norm(x, g):
    xf = x.astype(jnp.float32)
    y = xf * lax.rsqrt(jnp.mean(xf * xf, axis=-1, keepdims=True) + EPS)
    return (y * g.astype(jnp.float32)).astype(x.dtype)


def _t5_bucket(rel):
    half = REL_BUCKETS // 2
    max_exact = half // 2
    n = np.abs(rel)
    nl = np.maximum(n, max_exact).astype(np.float32)
    large = max_exact + (np.log(nl / max_exact) / np.log(REL_MAX_DISTANCE / max_exact)
                         * (half - max_exact)).astype(np.int32)
    large = np.minimum(large, half - 1)
    b = np.where(n < max_exact, n, large) + (rel > 0).astype(np.int32) * half
    return b.astype(np.int32)


def _dilated_attention(q, k, v, rel_bias):
    bsz, seq, heads, hd = q.shape
    scale = hd ** -0.5
    patterns = []
    for window, dil in DILATED_PATTERNS:
        half = window // (2 * dil)
        offs = dil * np.arange(-half, half + 1, dtype=np.int32)
        bias = rel_bias[jnp.asarray(_t5_bucket(offs))].T.astype(jnp.float32)
        patterns.append((jnp.asarray(offs), bias))

    def block(i):
        start = i * Q_BLOCK
        qb = lax.dynamic_slice_in_dim(q, start, Q_BLOCK, axis=1)
        qpos = start + jnp.arange(Q_BLOCK, dtype=jnp.int32)
        outs, lses = [], []
        for offs, bias in patterns:
            idx = qpos[:, None] + offs[None, :]
            valid = (idx >= 0) & (idx < seq)
            idx = jnp.clip(idx, 0, seq - 1)
            kg = jnp.take(k, idx, axis=1)
            vg = jnp.take(v, idx, axis=1)
            logits = jnp.einsum('bqhd,bqkhd->bqhk', qb, kg).astype(jnp.float32) * scale
            logits = logits + bias[None, None]
            logits = jnp.where(valid[None, :, None, :], logits, -1e30)
            m = jnp.max(logits, axis=-1, keepdims=True)
            p = jnp.exp(logits - m)
            s = jnp.sum(p, axis=-1, keepdims=True)
            o = jnp.einsum('bqhk,bqkhd->bqhd', (p / s).astype(v.dtype), vg)
            outs.append(o.astype(jnp.float32))
            lses.append((m + jnp.log(s))[..., 0])
        w = jax.nn.softmax(jnp.stack(lses, axis=0), axis=0)
        out = jnp.sum(w[..., None] * jnp.stack(outs, axis=0), axis=0)
        return out.astype(q.dtype)

    ob = lax.map(block, jnp.arange(seq // Q_BLOCK))
    return jnp.transpose(ob, (1, 0, 2, 3, 4)).reshape(bsz, seq, heads * hd)


def _hybrid_layer(x, w_in, gmlp_ws, gmlp_b, fnet_w, mix_gain, w_out, norm_mix,
                  norm_ffn, ffn_up, ffn_conv_w, ffn_conv_b, ffn_down, rel_bias):
    bsz, seq, _ = x.shape
    xn = _rms_norm(x, norm_mix)
    z = xn @ w_in
    o1 = 2 * GMLP_WIDTH
    o2 = o1 + 3 * ATTN_WIDTH
    za, zq, zc = z[..., :o1], z[..., o1:o2], z[..., o2:]

    za = jax.nn.gelu(za, approximate=False)
    u, vg = za[..., :GMLP_WIDTH], za[..., GMLP_WIDTH:]
    vg = vg.reshape(bsz, seq // CHUNK, CHUNK, GMLP_HEADS, HEAD_DIM)
    gate = jnp.einsum('hij,bcjhd->bcihd', gmlp_ws, vg) + gmlp_b.T[None, None, :, :, None]
    a_out = u * gate.reshape(bsz, seq, GMLP_WIDTH)

    q = zq[..., :ATTN_WIDTH].reshape(bsz, seq, ATTN_HEADS, HEAD_DIM)
    k = zq[..., ATTN_WIDTH:2 * ATTN_WIDTH].reshape(bsz, seq, ATTN_HEADS, HEAD_DIM)
    v = zq[..., 2 * ATTN_WIDTH:].reshape(bsz, seq, ATTN_HEADS, HEAD_DIM)
    b_out = _dilated_attention(q, k, v, rel_bias)

    zc = zc.reshape(bsz, seq, FNET_GROUPS, HEAD_DIM).astype(jnp.float32)
    f = jnp.fft.fft2(zc, axes=(1, 3), norm='ortho').real.astype(x.dtype)
    c_out = jnp.einsum('bsgc,gce->bsge', f, fnet_w).reshape(bsz, seq, FNET_WIDTH)

    ga = mix_gain[:GMLP_WIDTH]
    gb = mix_gain[GMLP_WIDTH:GMLP_WIDTH + ATTN_WIDTH]
    gc = mix_gain[GMLP_WIDTH + ATTN_WIDTH:]
    mixed = jnp.concatenate([_rms_norm(a_out, ga), _rms_norm(b_out, gb), _rms_norm(c_out, gc)], axis=-1)
    x = x + mixed @ w_out

    hn = _rms_norm(x, norm_ffn)
    h = hn @ ffn_up
    hp = jnp.pad(h, ((0, 0), (1, 1), (0, 0)))
    h = hp[:, :-2] * ffn_conv_w[0] + hp[:, 1:-1] * ffn_conv_w[1] + hp[:, 2:] * ffn_conv_w[2] + ffn_conv_b
    g, up = h[..., :D_FF], h[..., D_FF:]
    x = x + (jax.nn.silu(g) * up) @ ffn_down
    return x


def setup_inputs(seed: int = 0) -> dict:
    key = jax.random.key(seed)
    ks = jax.random.split(key, 16)
    f32 = jnp.float32
    nrm = lambda k, shape, s: jax.random.normal(k, shape, f32) * s
    return {
        'x': nrm(ks[0], (BATCH, SEQ, D_MODEL), 1.0),
        'w_in': nrm(ks[1], (DEPTH, D_MODEL, IN_WIDTH), D_MODEL ** -0.5),
        'gmlp_ws': nrm(ks[2], (DEPTH, GMLP_HEADS, CHUNK, CHUNK), CHUNK ** -0.5),
        'gmlp_b': 1.0 + nrm(ks[3], (DEPTH, GMLP_HEADS, CHUNK), 0.01),
        'fnet_w': nrm(ks[4], (DEPTH, FNET_GROUPS, HEAD_DIM, HEAD_DIM), HEAD_DIM ** -0.5),
        'mix_gain': 1.0 + nrm(ks[5], (DEPTH, D_MIX), 0.01),
        'w_out': nrm(ks[6], (DEPTH, D_MIX, D_MODEL), D_MIX ** -0.5),
        'norm_mix': 1.0 + nrm(ks[7], (DEPTH, D_MODEL), 0.01),
        'norm_ffn': 1.0 + nrm(ks[8], (DEPTH, D_MODEL), 0.01),
        'ffn_up': nrm(ks[9], (DEPTH, D_MODEL, 2 * D_FF), D_MODEL ** -0.5),
        'ffn_conv_w': nrm(ks[10], (DEPTH, CONV_WIDTH, 2 * D_FF), CONV_WIDTH ** -0.5),
        'ffn_conv_b': nrm(ks[11], (DEPTH, 2 * D_FF), 0.01),
        'ffn_down': nrm(ks[12], (DEPTH, D_FF, D_MODEL), D_FF ** -0.5),
        'rel_bias': nrm(ks[13], (REL_BUCKETS, ATTN_HEADS), 0.5),
        'final_norm': 1.0 + nrm(ks[14], (D_MODEL,), 0.01),
    }


def reference(x, w_in, gmlp_ws, gmlp_b, fnet_w, mix_gain, w_out, norm_mix, norm_ffn,
              ffn_up, ffn_conv_w, ffn_conv_b, ffn_down, rel_bias, final_norm):
    for l in range(DEPTH):
        x = _hybrid_layer(x, w_in[l], gmlp_ws[l], gmlp_b[l], fnet_w[l], mix_gain[l], w_out[l],
                          norm_mix[l], norm_ffn[l], ffn_up[l], ffn_conv_w[l], ffn_conv_b[l],
                          ffn_down[l], rel_bias)
    return _rms_norm(x, final_norm)
```

```cpp
#include <hip/hip_runtime.h>
#include <hip/hip_cooperative_groups.h>
#include <cstdio>
#include <cstdint>
namespace cg = cooperative_groups;

#ifndef ATT_NA
#define ATT_NA 8
#endif
#ifndef MK_PER_PHASE_LAUNCH
#define MK_PER_PHASE_LAUNCH 0
#endif

#define LAS __attribute__((address_space(3)))
typedef unsigned short bf16_t;
typedef short bf16x8 __attribute__((ext_vector_type(8)));
typedef short s16x4 __attribute__((ext_vector_type(4)));
typedef float f32x4 __attribute__((ext_vector_type(4)));
typedef float f32x2 __attribute__((ext_vector_type(2)));
typedef unsigned u32x4 __attribute__((ext_vector_type(4)));
typedef unsigned u32x2 __attribute__((ext_vector_type(2)));

constexpr int DM = 2048, SEQ = 4096, NTOK = 8192, DEPTH = 4;
constexpr int INW = 4608, ZW = 4096;
constexpr int DFF = 5632, DFF2 = 11264;
constexpr float EPS = 1e-6f;
constexpr int NTHREADS = 512, NWAVES = 8;

constexpr size_t MiB = 1u << 20;
constexpr size_t SZ_WIN = (size_t)ZW * DM * 2, SZ_WF = (size_t)1024 * DM * 2, SZ_WOUT = (size_t)DM * DM * 2, SZ_WUP = (size_t)DFF2 * DM * 2, SZ_WDN = (size_t)DM * DFF * 2;
constexpr size_t WS_WIN = 0;
constexpr size_t WS_WF = WS_WIN + DEPTH * SZ_WIN;
constexpr size_t WS_WOUT = WS_WF + DEPTH * SZ_WF;
constexpr size_t WS_WUP = WS_WOUT + DEPTH * SZ_WOUT;
constexpr size_t WS_WDN = WS_WUP + DEPTH * SZ_WUP;
constexpr size_t WS_DFT = WS_WDN + DEPTH * SZ_WDN;
constexpr size_t WS_TAB = WS_DFT + (size_t)4096 * 8192 * 2;
constexpr size_t WS_X = WS_TAB + 1 * MiB;
constexpr size_t WS_XN = WS_X + (size_t)NTOK * DM * 4;
constexpr size_t WS_Z = WS_XN + (size_t)NTOK * DM * 2;
constexpr size_t WS_T = WS_Z + (size_t)NTOK * ZW * 2;
constexpr size_t WS_CP = WS_T + (size_t)1024 * 8192 * 2;
constexpr size_t WS_AO = WS_CP + (size_t)4 * NTOK * 512 * 4;
constexpr size_t WS_BO = WS_AO + (size_t)NTOK * 512 * 2;
constexpr size_t WS_LSE = WS_BO + (size_t)3 * NTOK * 1024 * 2;
constexpr size_t WS_MIX = WS_LSE + (size_t)3 * NTOK * 16 * 4;
constexpr size_t WS_H = WS_MIX + (size_t)NTOK * DM * 2;
constexpr size_t WS_ACT = WS_H + (size_t)NTOK * DFF2 * 2;
constexpr size_t WS_CTL = WS_ACT + (size_t)NTOK * DFF * 2;
constexpr size_t CTL_BYTES = 65536;
constexpr size_t WS_R2048 = WS_CTL + CTL_BYTES;
constexpr size_t WS_END = WS_R2048 + 4096;

constexpr int LDS_BYTES = 147456;

__device__ __forceinline__ unsigned f2bf(float f) { unsigned u = __builtin_bit_cast(unsigned, f); return (u + 0x7fffu + ((u >> 16) & 1u)) >> 16; }
typedef __bf16 hwbf16x2 __attribute__((ext_vector_type(2)));
__device__ __forceinline__ unsigned pk2(float lo, float hi) { const f32x2 v = {lo, hi}; const hwbf16x2 b = __builtin_convertvector(v, hwbf16x2); return __builtin_bit_cast(unsigned, b); }
__device__ __forceinline__ float bflo(unsigned w) { return __uint_as_float(w << 16); }
__device__ __forceinline__ float bfhi(unsigned w) { return __uint_as_float(w & 0xffff0000u); }
__device__ __forceinline__ float wave_sum(float v) {
#pragma unroll
    for (int o = 1; o < 64; o <<= 1) v += __shfl_xor(v, o);
    return v;
}
#define LDS_WAIT() asm volatile("s_waitcnt lgkmcnt(0)" ::: "memory")
__device__ __forceinline__ void unpack8(const u32x4 w, float* v) { v[0] = bflo(w.x); v[1] = bfhi(w.x); v[2] = bflo(w.y); v[3] = bfhi(w.y); v[4] = bflo(w.z); v[5] = bfhi(w.z); v[6] = bflo(w.w); v[7] = bfhi(w.w); }
__device__ __forceinline__ int opaque_tid() { int t = threadIdx.x; asm volatile("" : "+v"(t)); return t; }
__device__ __forceinline__ int opaque_bid() { int t = blockIdx.x; asm volatile("" : "+s"(t)); return t; }

namespace pg8 {
constexpr int BM = 256, BK = 64, HALF = 128, HTB = HALF * BK * 2, STAGE_BYTES = 8 * HTB, NXCD = 8, WGM = 8;
__device__ __forceinline__ int lds_byte(int r, int c) { const int st = (r >> 4) * 2 + (c >> 5), rr = r & 15, cc = c & 31, ob = rr * 64 + cc * 2; return st * 1024 + (ob ^ (((ob >> 9) & 1) << 5)); }
__device__ __forceinline__ void stage_rc(int b, int& R, int& C) { const int st = b / 1024, sb = b % 1024, swz = sb ^ (((sb >> 9) & 1) << 5); R = (st >> 1) * 16 + swz / 64; C = (st & 1) * 32 + (swz % 64) / 2; }
__device__ __forceinline__ int perm32(int rho) { const int n = rho >> 4, i = rho & 15; return 8 * (i >> 2) + 4 * n + (i & 3); }

struct Unit { const char* A; const char* B; char* O; const float* R; int ldc; int flag; };

__device__ __forceinline__ unsigned cvt_pk_bf16(float lo, float hi) { unsigned r; asm volatile("v_cvt_pk_bf16_f32 %0, %1, %2" : "=v"(r) : "v"(lo), "v"(hi)); return r; }
__device__ __forceinline__ f32x2 gelu_pk(f32x2 v) {
    const f32x2 av = __builtin_elementwise_abs(v), d = av * 0.2316418882f + 1.0f;
    f32x2 t; t.x = __builtin_amdgcn_rcpf(d.x); t.y = __builtin_amdgcn_rcpf(d.y);
    f32x2 q = t * 0.5307027145f + (-0.7265760135f); q = q * t + 0.7107068705f; q = q * t + (-0.142248368f); q = q * t + 0.127414796f; q = q * t;
    const f32x2 s = (v * v) * (-0.72134752044f);
    f32x2 e; e.x = __builtin_amdgcn_exp2f(s.x); e.y = __builtin_amdgcn_exp2f(s.y);
    const f32x2 m = v * (q * e), r = v - m;
    f32x2 o; o.x = v.x < 0.f ? m.x : r.x; o.y = v.y < 0.f ? m.y : r.y; return o;
}

__device__ __forceinline__ void store16_wt(void* p, u32x4 v) { asm volatile("s_nop 1\n\tglobal_store_dwordx4 %0, %1, off sc0 sc1\n\ts_nop 2" :: "v"(p), "v"(v) : "memory"); }
struct EpiBf16 {
    static constexpr bool PERM = true;
    __device__ __forceinline__ void operator()(const f32x4 (&acc)[2][2][4][2], const Unit& u, int wr, int wc, int fr, int fq) const {
        bf16_t* base = (bf16_t*)u.O + (size_t)(wr * 64 + fr) * u.ldc + wc * 32 + 8 * fq;
        const bool act = (u.flag & 1) != 0;
#pragma unroll
        for (int ai = 0; ai < 2; ++ai)
#pragma unroll
            for (int m = 0; m < 4; ++m) { bf16_t* rowp = base + (size_t)(ai * HALF + m * 16) * u.ldc;
#pragma unroll
                for (int bj = 0; bj < 2; ++bj) { f32x4 v0 = acc[ai][bj][m][0], v1 = acc[ai][bj][m][1];
                    if (act) { f32x2 a = gelu_pk((f32x2){v0[0], v0[1]}), b = gelu_pk((f32x2){v0[2], v0[3]}), c = gelu_pk((f32x2){v1[0], v1[1]}), d = gelu_pk((f32x2){v1[2], v1[3]});
                        v0 = (f32x4){a.x, a.y, b.x, b.y}; v1 = (f32x4){c.x, c.y, d.x, d.y}; }
                    u32x4 w; w.x = cvt_pk_bf16(v0[0], v0[1]); w.y = cvt_pk_bf16(v0[2], v0[3]); w.z = cvt_pk_bf16(v1[0], v1[1]); w.w = cvt_pk_bf16(v1[2], v1[3]);
                    *(u32x4*)(rowp + bj * HALF) = w; } }
    }
};
struct EpiF32 {
    static constexpr bool PERM = true;
    __device__ __forceinline__ void operator()(const f32x4 (&acc)[2][2][4][2], const Unit& u, int wr, int wc, int fr_in, int fq_in) const {
        int tt = threadIdx.x; asm volatile("" : "+v"(tt)); const int fr = tt & 15, fq = (tt >> 4) & 3; (void)fr_in; (void)fq_in;
        const size_t off0 = (size_t)(wr * 64 + fr) * u.ldc + wc * 32 + 8 * fq;
        bf16_t* O = (bf16_t*)u.O; const bool r32 = (u.flag & 1) != 0;
        const float* R32 = u.R; const bf16_t* R16 = (const bf16_t*)u.R;
#pragma unroll
        for (int ai = 0; ai < 2; ++ai)
#pragma unroll
            for (int mh = 0; mh < 2; ++mh) {
                f32x4 rv[2][2][2];
                if (r32) {
#pragma unroll
                    for (int m2 = 0; m2 < 2; ++m2)
#pragma unroll
                        for (int bj = 0; bj < 2; ++bj)
#pragma unroll
                            for (int n = 0; n < 2; ++n) rv[m2][bj][n] = *(const f32x4*)(R32 + off0 + (size_t)(ai * HALF + (2 * mh + m2) * 16) * u.ldc + bj * HALF + 4 * n);
                } else {
                    u32x4 rb[2][2];
#pragma unroll
                    for (int m2 = 0; m2 < 2; ++m2)
#pragma unroll
                        for (int bj = 0; bj < 2; ++bj) rb[m2][bj] = *(const u32x4*)(R16 + off0 + (size_t)(ai * HALF + (2 * mh + m2) * 16) * u.ldc + bj * HALF);
#pragma unroll
                    for (int m2 = 0; m2 < 2; ++m2)
#pragma unroll
                        for (int bj = 0; bj < 2; ++bj) { const u32x4 t = rb[m2][bj]; rv[m2][bj][0] = (f32x4){bflo(t.x), bfhi(t.x), bflo(t.y), bfhi(t.y)}; rv[m2][bj][1] = (f32x4){bflo(t.z), bfhi(t.z), bflo(t.w), bfhi(t.w)}; }
                }
                asm volatile("" ::: "memory");
#pragma unroll
                for (int m2 = 0; m2 < 2; ++m2) { const int m = 2 * mh + m2; const size_t off = off0 + (size_t)(ai * HALF + m * 16) * u.ldc;
#pragma unroll
                    for (int bj = 0; bj < 2; ++bj) { const f32x4 v0 = acc[ai][bj][m][0] + rv[m2][bj][0], v1 = acc[ai][bj][m][1] + rv[m2][bj][1];
                        u32x4 w; w.x = cvt_pk_bf16(v0[0], v0[1]); w.y = cvt_pk_bf16(v0[2], v0[3]); w.z = cvt_pk_bf16(v1[0], v1[1]); w.w = cvt_pk_bf16(v1[2], v1[3]);
                        *(u32x4*)(O + off + bj * HALF) = w; } }
                asm volatile("" ::: "memory");
            }
    }
};

__device__ __forceinline__ float dpp_ror1(float v) { return __int_as_float(__builtin_amdgcn_update_dpp(0, __float_as_int(v), 0x121, 0xf, 0xf, false)); }
__device__ __forceinline__ float dpp_rol1(float v) { return __int_as_float(__builtin_amdgcn_update_dpp(0, __float_as_int(v), 0x12F, 0xf, 0xf, false)); }
struct EpiConvGate {
    static constexpr bool PERM = true;
    const float* cw; const float* cb; LAS float* xl;
    __device__ __forceinline__ void operator()(const f32x4 (&acc)[2][2][4][2], const Unit& u, int wr, int wc, int fr_in, int fq_in) const {
        LAS float* X = xl;
        LAS float* W = xl + 2048;
        int fr = fr_in, fq = fq_in, t = threadIdx.x; asm volatile("" : "+v"(fr), "+v"(fq), "+v"(t));
        const int cl = wc * 32 + 8 * fq;
        float wl[4] = {0.f, 0.f, 0.f, 0.f};
        { const int col0 = (int)(u.R - cw);
          if (t < 256) { const int bj = t >> 7, c = t & 127; const int gc = bj * DFF + col0 + c; wl[0] = cw[gc]; wl[1] = cw[DFF2 + gc]; wl[2] = cw[2 * DFF2 + gc]; wl[3] = cb[gc]; } }
#pragma unroll
        for (int ai = 0; ai < 2; ++ai) { const int Bk = 2 * ai + wr;
#pragma unroll
            for (int bj = 0; bj < 2; ++bj)
#pragma unroll
                for (int n = 0; n < 2; ++n) {
                    if (fr == 0) *(LAS f32x4*)(X + ((Bk * 2 + 0) * 2 + bj) * 128 + cl + 4 * n) = acc[ai][bj][0][n];
                    if (fr == 15) *(LAS f32x4*)(X + ((Bk * 2 + 1) * 2 + bj) * 128 + cl + 4 * n) = acc[ai][bj][3][n]; } }
        if (t < 256) { const int bj = t >> 7, c = t & 127; W[(0 * 2 + bj) * 128 + c] = wl[0]; W[(1 * 2 + bj) * 128 + c] = wl[1]; W[(2 * 2 + bj) * 128 + c] = wl[2]; W[(3 * 2 + bj) * 128 + c] = wl[3]; }
        asm volatile("s_waitcnt vmcnt(0) lgkmcnt(0)" ::: "memory"); __builtin_amdgcn_s_barrier(); asm volatile("" ::: "memory");
        const int j = u.flag;
        bf16_t* obase = (bf16_t*)u.O + cl;
#pragma unroll
        for (int n = 0; n < 2; ++n) {
            f32x4 wv[4][2];
#pragma unroll
            for (int k = 0; k < 4; ++k)
#pragma unroll
                for (int bj = 0; bj < 2; ++bj) wv[k][bj] = *(const LAS f32x4*)(W + (k * 2 + bj) * 128 + cl + 4 * n);
#pragma unroll
            for (int ai = 0; ai < 2; ++ai) { const int Bk = 2 * ai + wr;
#pragma unroll
                for (int m = 0; m < 4; ++m) {
                    const int r = 128 * ai + 64 * wr + 16 * m + fr, tb = 254 * j + r - 1;
                    f32x4 res[2];
#pragma unroll
                    for (int bj = 0; bj < 2; ++bj) {
                        const f32x4 cur = acc[ai][bj][m][n];
                        f32x4 pe, ne;
                        if (m > 0) { const f32x4 q = acc[ai][bj][m > 0 ? m - 1 : 0][n]; pe = (f32x4){dpp_ror1(q[0]), dpp_ror1(q[1]), dpp_ror1(q[2]), dpp_ror1(q[3])}; }
                        else pe = *(const LAS f32x4*)(X + (((Bk > 0 ? Bk - 1 : 0) * 2 + 1) * 2 + bj) * 128 + cl + 4 * n);
                        if (m < 3) { const f32x4 q = acc[ai][bj][m < 3 ? m + 1 : 3][n]; ne = (f32x4){dpp_rol1(q[0]), dpp_rol1(q[1]), dpp_rol1(q[2]), dpp_rol1(q[3])}; }
                        else ne = *(const LAS f32x4*)(X + (((Bk < 3 ? Bk + 1 : 3) * 2 + 0) * 2 + bj) * 128 + cl + 4 * n);
                        f32x4 pvv, nvv;
#pragma unroll
                        for (int e = 0; e < 4; ++e) {
                            float pv = __int_as_float(__builtin_amdgcn_update_dpp(__float_as_int(pe[e]), __float_as_int(cur[e]), 0x111, 0xf, 0xf, false));
                            float nv = __int_as_float(__builtin_amdgcn_update_dpp(__float_as_int(ne[e]), __float_as_int(cur[e]), 0x101, 0xf, 0xf, false));
                            if (ai == 0 && m == 0) pv = (tb == 0) ? 0.f : pv;
                            if (ai == 0 && m == 2) nv = (tb == SEQ - 1) ? 0.f : nv;
                            pvv[e] = pv; nvv[e] = nv; }
                        res[bj] = pvv * wv[0][bj] + (cur * wv[1][bj] + (nvv * wv[2][bj] + wv[3][bj]));
                    }
                    f32x4 y;
                    { const f32x4 G = res[0], t = G * -1.4426950408889634f;
                      f32x4 den; den[0] = __builtin_amdgcn_exp2f(t[0]); den[1] = __builtin_amdgcn_exp2f(t[1]); den[2] = __builtin_amdgcn_exp2f(t[2]); den[3] = __builtin_amdgcn_exp2f(t[3]);
                      den = den + 1.0f;
                      f32x4 rc; rc[0] = __builtin_amdgcn_rcpf(den[0]); rc[1] = __builtin_amdgcn_rcpf(den[1]); rc[2] = __builtin_amdgcn_rcpf(den[2]); rc[3] = __builtin_amdgcn_rcpf(den[3]);
                      y = (G * res[1]) * rc; }
                    u32x2 w; w.x = cvt_pk_bf16(y[0], y[1]); w.y = cvt_pk_bf16(y[2], y[3]);
                    if (r >= 1 && r <= 254 && tb < SEQ) *(u32x2*)(obase + (size_t)r * DFF + 4 * n) = w;
                } }
        }
    }
};

template <class Epi, class Sched>
__device__ __forceinline__ void gemm_phase(LAS unsigned char* lds, const int K, const int lda, const int ldb, const Sched& S, const Epi& E, const int bhalf_rows = 128) {
    const int tid = opaque_tid(), wid = __builtin_amdgcn_readfirstlane(tid >> 6), lane = tid & 63, wr = wid >> 2, wc = wid & 3, fr = lane & 15, fq = lane >> 4;
    const int nt = K / BK;
    unsigned voffA[2], voffB[2];
#pragma unroll
    for (int i = 0; i < 2; ++i) { int R, C; stage_rc(tid * 16 + i * 8192, R, C); const int Rb = Epi::PERM ? ((R & ~31) + perm32(R & 31)) : R;
        voffA[i] = (unsigned)(R * lda + C) * 2u; voffB[i] = (unsigned)(Rb * ldb + C) * 2u; }
    const size_t kstep = (size_t)(BK * 2);
    const size_t hstepA = (size_t)HALF * lda * 2, hstepB = (size_t)bhalf_rows * ldb * 2;
    const unsigned ldsw = (unsigned)wid * 1024u;
    const int aoff = lds_byte(wr * 64 + fr, fq * 8), boff = lds_byte(wc * 32 + fr, fq * 8);
#define PG8_SA(b, h) (((b) * 2 + (h)) * HTB)
#define PG8_SB(b, h) ((4 + (b) * 2 + (h)) * HTB)
#define PG8_STAGE(bufoff, gbase, voff) do { _Pragma("unroll") for (int _i = 0; _i < 2; ++_i) \
        __builtin_amdgcn_global_load_lds((const unsigned*)((const char*)(gbase) + (voff)[_i]), (LAS unsigned*)(lds + (bufoff) + ldsw + _i * 8192), 16, 0, 0); } while (0)
#define PG8_LDA(dst, b, h) do { _Pragma("unroll") for (int m = 0; m < 4; ++m) _Pragma("unroll") for (int k = 0; k < 2; ++k) dst[m][k] = *(const LAS bf16x8*)(lds + PG8_SA(b, h) + aoff + m * 2048 + k * 1024); } while (0)
#define PG8_LDB(dst, b, h) do { _Pragma("unroll") for (int n = 0; n < 2; ++n) _Pragma("unroll") for (int k = 0; k < 2; ++k) dst[n][k] = *(const LAS bf16x8*)(lds + PG8_SB(b, h) + boff + n * 2048 + k * 1024); } while (0)
#define PG8_MMA(ai, bj, At, Bt) do { __builtin_amdgcn_s_setprio(1); _Pragma("unroll") for (int m = 0; m < 4; ++m) _Pragma("unroll") for (int n = 0; n < 2; ++n) _Pragma("unroll") for (int k = 0; k < 2; ++k) \
        acc[ai][bj][m][n] = __builtin_amdgcn_mfma_f32_16x16x32_bf16(Bt[n][k], At[m][k], acc[ai][bj][m][n], 0, 0, 0); __builtin_amdgcn_s_setprio(0); } while (0)
#define PG8_WAIT_V(n) asm volatile("s_waitcnt vmcnt(" #n ")" ::: "memory")
#define PG8_WAIT_L(n) asm volatile("s_waitcnt lgkmcnt(" #n ")" ::: "memory")
#define PG8_BAR __builtin_amdgcn_s_barrier()
#define PG8_SCHED __builtin_amdgcn_sched_barrier(0)
    Unit cur, nxt; int ui = 0;
    if (!S.next(0, cur)) return;
    f32x4 acc[2][2][4][2];
#pragma unroll
    for (int a = 0; a < 2; ++a)
#pragma unroll
        for (int b = 0; b < 2; ++b)
#pragma unroll
            for (int m = 0; m < 4; ++m)
#pragma unroll
                for (int n = 0; n < 2; ++n) acc[a][b][m][n] = (f32x4){0.f, 0.f, 0.f, 0.f};
    bf16x8 At[4][2], B0[2][2], B1[2][2];
    const char* cA = cur.A; const char* cB = cur.B;
    PG8_STAGE(PG8_SB(0, 0), cB, voffB); PG8_STAGE(PG8_SB(0, 1), cB + hstepB, voffB); PG8_STAGE(PG8_SA(0, 0), cA, voffA); PG8_STAGE(PG8_SA(0, 1), cA + hstepA, voffA);
    if (wr == 1) PG8_BAR;
    PG8_WAIT_V(2); PG8_BAR;
    PG8_STAGE(PG8_SB(1, 0), cB + kstep, voffB); PG8_STAGE(PG8_SA(1, 0), cA + kstep, voffA); PG8_STAGE(PG8_SB(1, 1), cB + hstepB + kstep, voffB);
    PG8_WAIT_V(6); PG8_BAR;
    for (;;) {
        const bool has_next = S.next(ui + 1, nxt);
        const char* nA = has_next ? nxt.A : cA; const char* nB = has_next ? nxt.B : cB;
        for (int t = 0; t < nt; t += 2) {
            const bool last = (t == nt - 2);
            const char* a1 = cA + (size_t)(t + 1) * kstep;
            const char* a2 = last ? nA : cA + (size_t)(t + 2) * kstep; const char* b2 = last ? nB : cB + (size_t)(t + 2) * kstep;
            const char* a3 = a2 + kstep; const char* b3 = b2 + kstep;
            PG8_LDB(B0, 0, 0); PG8_LDB(B1, 0, 1); PG8_SCHED; PG8_LDA(At, 0, 0); PG8_STAGE(PG8_SA(1, 1), a1 + hstepA, voffA);
            PG8_WAIT_V(8); PG8_WAIT_L(0); PG8_BAR; PG8_MMA(0, 0, At, B0); PG8_MMA(0, 1, At, B1); PG8_BAR; PG8_SCHED;
            PG8_LDA(At, 0, 1); PG8_STAGE(PG8_SB(0, 0), b2, voffB); PG8_STAGE(PG8_SB(0, 1), b2 + hstepB, voffB); PG8_STAGE(PG8_SA(0, 0), a2, voffA);
            PG8_WAIT_V(8); PG8_WAIT_L(0); PG8_BAR; PG8_MMA(1, 0, At, B0); PG8_MMA(1, 1, At, B1); PG8_BAR; PG8_SCHED;
            PG8_LDB(B0, 1, 0); PG8_LDB(B1, 1, 1); PG8_SCHED; PG8_LDA(At, 1, 0); PG8_STAGE(PG8_SA(0, 1), a2 + hstepA, voffA);
            PG8_WAIT_V(8); PG8_WAIT_L(0); PG8_BAR; PG8_MMA(0, 0, At, B0); PG8_MMA(0, 1, At, B1); PG8_BAR; PG8_SCHED;
            PG8_LDA(At, 1, 1); PG8_STAGE(PG8_SB(1, 0), b3, voffB); PG8_STAGE(PG8_SB(1, 1), b3 + hstepB, voffB); PG8_STAGE(PG8_SA(1, 0), a3, voffA);
            PG8_WAIT_V(8); PG8_WAIT_L(0); PG8_BAR; PG8_MMA(1, 0, At, B0); PG8_MMA(1, 1, At, B1); PG8_BAR; PG8_SCHED;
        }
        if (wr == 0) PG8_BAR;
        E(acc, cur, wr, wc, fr, fq);
        if (!has_next) break;
#pragma unroll
        for (int a = 0; a < 2; ++a)
#pragma unroll
            for (int b = 0; b < 2; ++b)
#pragma unroll
                for (int m = 0; m < 4; ++m)
#pragma unroll
                    for (int n = 0; n < 2; ++n) acc[a][b][m][n] = (f32x4){0.f, 0.f, 0.f, 0.f};
        cur = nxt; cA = nA; cB = nB; ++ui;
        if (wr == 1) PG8_BAR;
    }
    PG8_WAIT_V(0);
    PG8_BAR;
#undef PG8_SA
#undef PG8_SB
#undef PG8_STAGE
#undef PG8_LDA
#undef PG8_LDB
#undef PG8_MMA
#undef PG8_WAIT_V
#undef PG8_WAIT_L
#undef PG8_BAR
#undef PG8_SCHED
}
}

struct Sched {
    int kind, G, c;
    const char* A0; const char* B0; char* O0; const float* R0;
    const char* A1; const char* B1; char* O1;
    int nM, nN, K;
    int r32;
    __device__ __forceinline__ static void order(int wgid, int nwg, int nM, int nN, int& pm, int& pn) {
        { const int q = nwg / 8, r = nwg % 8, xcd = wgid % 8, off = wgid / 8; wgid = (xcd < r ? xcd * (q + 1) : r * (q + 1) + (xcd - r) * q) + off; }
        const int nig = 8 * nN, gid = wgid / nig, fm = gid * 8, gsz = (nM - fm) < 8 ? (nM - fm) : 8;
        pm = fm + ((wgid % nig) % gsz); pn = (wgid % nig) / gsz;
    }
    __device__ __forceinline__ bool next(int i, pg8::Unit& u) const {
        const int L = i * G + c;
        if (kind == 0) {
            if (L < 512) { int pm, pn; order(L, 512, 32, 16, pm, pn);
                u.A = A0 + (size_t)pm * 256 * DM * 2; u.B = B0 + (size_t)pn * 256 * DM * 2; u.O = O0 + ((size_t)pm * 256 * ZW + pn * 256) * 2; u.R = nullptr; u.ldc = ZW; u.flag = 0; return true; }
            const int L1 = L - 512; if (L1 >= 128) return false;
            int pm, pn; order(L1, 128, 4, 32, pm, pn);
            u.A = A1 + (size_t)pm * 256 * DM * 2; u.B = B1 + (size_t)pn * 256 * DM * 2;
            u.O = O1 + ((size_t)(pn >> 4) * 512 * 8192 + (size_t)(pm & 1) * 256 * 8192 + (size_t)(pm >> 1) * 4096 + (size_t)(pn & 15) * 256) * 2;
            u.R = nullptr; u.ldc = 8192; u.flag = 0; return true;
        } else if (kind == 2) {
            if (L >= 128) return false;
            const int xcd = L & 7, j = L >> 3, ks = xcd & 3, pm = (xcd >> 2) * 4 + (j & 3), pn = j >> 2;
            u.A = A0 + ((size_t)pm * 256 * 8192 + (size_t)ks * 2048) * 2; u.B = B0 + ((size_t)pn * 256 * 8192 + (size_t)ks * 2048) * 2;
            u.O = O0 + ((((size_t)ks * 2 + (pn >> 1)) * 2048 + (size_t)pm * 256) * 512 + (size_t)(pn & 1) * 256) * 2; u.R = nullptr; u.ldc = 512; u.flag = 0; return true;
        } else if (kind == 3) {
            if (L >= nM * nN) return false;
            int pm, pn; order(L, nM * nN, nM, nN, pm, pn);
            u.A = A0 + (size_t)pm * 256 * K * 2; u.B = B0 + (size_t)pn * 256 * K * 2; u.O = O0 + ((size_t)pm * 256 * DM + pn * 256) * 2; u.R = (const float*)((const char*)R0 + ((size_t)pm * 256 * DM + pn * 256) * (r32 ? 4 : 2)); u.ldc = DM; u.flag = r32; return true;
        } else if (kind == 5) {
            if (L >= 34 * 44) return false;
            int pm, pn; order(L, 34 * 44, 34, 44, pm, pn);
            const int b = pm / 17, j = pm % 17; const long row0 = (long)b * SEQ + 254 * j - 1;
            u.A = A0 + row0 * DM * 2; u.B = B0 + (size_t)pn * 128 * DM * 2; u.O = O0 + (row0 * DFF + pn * 128) * 2; u.R = R0 + pn * 128; u.ldc = DFF; u.flag = j; return true;
        } else {
            if (L >= nM * nN) return false;
            int pm, pn; order(L, nM * nN, nM, nN, pm, pn);
            u.A = A0 + (size_t)pm * 256 * K * 2; u.B = B0 + (size_t)pn * 256 * K * 2; u.O = O0 + ((size_t)pm * 256 * DFF2 + pn * 256) * 2; u.R = nullptr; u.ldc = DFF2; u.flag = 0; return true;
        }
    }
};


#define XB_TMO      128
#define XB_XCNT(j)  (256  + 64 * (j))
#define XB_XSUB(j)  (1280 + 64 * (j))
#define XB_XGEN(j)  (2304 + 64 * (j))
#define XB_TOP      3328
#define XB_TOPGEN   3392
#define XCD_BAR_WORDS 3456
#define XB_SPIN_CAP (1u << 22)
__device__ __forceinline__ unsigned xb_ld(unsigned* p)              { return __hip_atomic_load(p, __ATOMIC_RELAXED, __HIP_MEMORY_SCOPE_AGENT); }
__device__ __forceinline__ unsigned xb_add(unsigned* p, unsigned v) { return __hip_atomic_fetch_add(p, v, __ATOMIC_RELAXED, __HIP_MEMORY_SCOPE_AGENT); }
__device__ __forceinline__ unsigned xb_xcc_id() { return (unsigned)__builtin_amdgcn_s_getreg((3 << 11) | 20) & 0xFu; }
#define XB_SPIN(cond, bar) do { unsigned _sp = 0; while (cond) { __builtin_amdgcn_s_sleep(1); \
    if ((++_sp & 255u) == 0u) { if (xb_ld(&(bar)[XB_TMO])) break; if (_sp > XB_SPIN_CAP) { atomicAdd(&(bar)[XB_TMO], 1u); break; } } } } while (0)
struct XcdBarrier { unsigned* bar; unsigned x; volatile LAS unsigned* st; };
__device__ __forceinline__ XcdBarrier xcd_barrier_post(unsigned* bar, volatile LAS unsigned* st) {
    XcdBarrier b; b.bar = bar; b.x = xb_xcc_id(); b.st = st;
    if (threadIdx.x == 0) (void)xb_add(&bar[XB_XCNT(b.x)], 1u);
    return b;
}
__device__ __forceinline__ void xcd_barrier_complete(unsigned* bar, unsigned x, unsigned& nloc, unsigned& nx) {
    const unsigned G = gridDim.x * gridDim.y * gridDim.z;
    unsigned sum, cnt, mine, sp = 0u;
    for (;;) {
        sum = 0u; cnt = 0u; mine = 0u;
#pragma unroll
        for (unsigned j = 0; j < 16; ++j) { const unsigned c = xb_ld(&bar[XB_XCNT(j)]); sum += c; cnt += (c > 0u) ? 1u : 0u; mine = (j == x) ? c : mine; }
        if (sum == G) break;
        __builtin_amdgcn_s_sleep(1);
        if ((++sp & 255u) == 0u) { if (xb_ld(&bar[XB_TMO])) break; if (sp > XB_SPIN_CAP) { atomicAdd(&bar[XB_TMO], 1u); break; } }
    }
    nloc = mine > 0u ? mine : 1u; nx = cnt > 0u ? cnt : 1u;
}
__device__ __forceinline__ void xcd_barrier(const XcdBarrier& b) {
    asm volatile("s_waitcnt vmcnt(0)" ::: "memory");
    __syncthreads();
    if (threadIdx.x == 0) {
        unsigned* bar = b.bar;
        __builtin_amdgcn_s_waitcnt(0);
        unsigned nloc = b.st[0], nx = b.st[1];
        if (nloc == 0u) { xcd_barrier_complete(bar, b.x, nloc, nx); b.st[0] = nloc; b.st[1] = nx; }
        const unsigned old = xb_add(&bar[XB_XSUB(b.x)], 1u);
        const unsigned gen = old / nloc;
        if (old + 1u == (gen + 1u) * nloc) {
            __builtin_amdgcn_fence(__ATOMIC_RELEASE, "agent");
            asm volatile("s_waitcnt vmcnt(0)" ::: "memory");
            const unsigned og = xb_add(&bar[XB_TOP], 1u);
            const unsigned tg = og / nx;
            if (og + 1u == (tg + 1u) * nx) xb_add(&bar[XB_TOPGEN], 1u);
            else XB_SPIN(xb_ld(&bar[XB_TOPGEN]) == tg, bar);
            __builtin_amdgcn_fence(__ATOMIC_ACQUIRE, "agent");
            xb_add(&bar[XB_XGEN(b.x)], 1u);
            asm volatile("s_waitcnt vmcnt(0)" ::: "memory");
        } else {
            XB_SPIN(xb_ld(&bar[XB_XGEN(b.x)]) == gen, bar);
            __builtin_amdgcn_fence(__ATOMIC_ACQUIRE, "agent");
            asm volatile("s_waitcnt vmcnt(0)" ::: "memory");
        }
    }
    __syncthreads();
}

struct Params {
    const float* x; const float* w_in; const float* gmlp_ws; const float* gmlp_b; const float* fnet_w; const float* mix_gain; const float* w_out; const float* norm_mix;
    const float* norm_ffn; const float* ffn_up; const float* conv_w; const float* conv_b; const float* ffn_down; const float* rel_bias; const float* final_norm;
    float* out; unsigned char* ws; int ph_lo, ph_hi;
};

__device__ __forceinline__ void transpose_item(const float* W, int ldw, int K, bf16_t* WT, int nblk, LAS float* scr, int item, int lane) {
    const int kb = item / nblk, nb = item % nblk, k0 = 64 * kb, n0 = 64 * nb;
    f32x4 v[16];
#pragma unroll
    for (int i = 0; i < 16; ++i) v[i] = *(const f32x4*)(W + (size_t)(k0 + (lane >> 4) + 4 * i) * ldw + n0 + (lane & 15) * 4);
#pragma unroll
    for (int i = 0; i < 16; ++i) { LAS float* d = scr + ((lane >> 4) + 4 * i) * 65 + (lane & 15) * 4; d[0] = v[i][0]; d[1] = v[i][1]; d[2] = v[i][2]; d[3] = v[i][3]; }
    LDS_WAIT();
    const int c = lane & 7;
#pragma unroll
    for (int j = 0; j < 8; ++j) { const int n = (lane >> 3) + 8 * j; const LAS float* s = scr + (8 * c) * 65 + n;
        u32x4 o; o.x = pk2(s[0 * 65], s[1 * 65]); o.y = pk2(s[2 * 65], s[3 * 65]); o.z = pk2(s[4 * 65], s[5 * 65]); o.w = pk2(s[6 * 65], s[7 * 65]);
        *(u32x4*)(WT + (size_t)(n0 + n) * K + k0 + 8 * c) = o; }
    LDS_WAIT();
}

__device__ __forceinline__ int t5_bucket(int rel) {
    const int n = rel < 0 ? -rel : rel; int b;
    if (n < 8) b = n; else { const float v = logf((float)n / 8.0f) / logf(128.0f) * 8.0f; int lg = 8 + (int)v; b = lg < 15 ? lg : 15; }
    return b + (rel > 0 ? 16 : 0);
}

constexpr int TI_IN = (DM / 64) * (ZW / 64), TI_OUT = (DM / 64) * (DM / 64), TI_UP = (DM / 64) * (DFF2 / 64), TI_DN = (DFF / 64) * (DM / 64), TI_L = TI_IN + TI_OUT + TI_UP + TI_DN;
constexpr int TI_DEFER = 9472;
__device__ __forceinline__ void transpose_range(const Params& p, LAS unsigned char* lds, int l, int lo, int hi, int gw, int NGW, int wave, int lane) {
    unsigned char* ws = p.ws; LAS float* scr = (LAS float*)(lds + wave * 16640);
    for (int it = lo + gw; it < hi; it += NGW) {
        int r = it;
        if (r < TI_IN) { transpose_item(p.w_in + (size_t)l * DM * INW, INW, DM, (bf16_t*)(ws + WS_WIN + l * SZ_WIN), ZW / 64, scr, r, lane); continue; } r -= TI_IN;
        if (r < TI_OUT) { transpose_item(p.w_out + (size_t)l * DM * DM, DM, DM, (bf16_t*)(ws + WS_WOUT + l * SZ_WOUT), DM / 64, scr, r, lane); continue; } r -= TI_OUT;
        if (r < TI_UP) { transpose_item(p.ffn_up + (size_t)l * DM * DFF2, DFF2, DM, (bf16_t*)(ws + WS_WUP + l * SZ_WUP), DFF2 / 64, scr, r, lane); continue; } r -= TI_UP;
        transpose_item(p.ffn_down + (size_t)l * DFF * DM, DM, DFF, (bf16_t*)(ws + WS_WDN + l * SZ_WDN), DM / 64, scr, r, lane);
    }
}

__device__ __forceinline__ void phase_prep(const Params& p, LAS unsigned char* lds) {
    const int tid = opaque_tid(), lane = tid & 63, wave = tid >> 6; const int bid = opaque_bid();
    unsigned char* ws = p.ws;
    {
        const int gw = bid * NWAVES + wave, NGW = gridDim.x * NWAVES; const bool defer = (gridDim.x == 256);
        for (int l = 0; l < (defer ? 1 : DEPTH); ++l) transpose_range(p, lds, l, 0, defer ? TI_IN : TI_L, gw, NGW, wave, lane);
    }
    __syncthreads();
    {
        LAS float* ctab = (LAS float*)lds;
        LAS float* Mf = (LAS float*)(lds + 1024);
        if (tid < 64) ctab[tid] = cospif((float)tid * (1.0f / 32.0f));
        for (int grp = bid; grp < DEPTH * 2 * 8 * 4; grp += gridDim.x) {
            const int l = grp >> 6, part = (grp >> 5) & 1, g = (grp >> 2) & 7, kc4 = grp & 3;
            __syncthreads();
            const float* fw = p.fnet_w + ((size_t)l * 8 + g) * 64 * 64;
            LAS float* FW = (LAS float*)(lds + 1024 + 16384);
            { const f32x4 f0 = *(const f32x4*)(fw + tid * 8), f1 = *(const f32x4*)(fw + tid * 8 + 4); *(LAS f32x4*)(FW + tid * 8) = f0; *(LAS f32x4*)(FW + tid * 8 + 4) = f1; }
            __syncthreads();
            for (int idx = tid; idx < 4096; idx += NTHREADS) { const int c = idx >> 6, e = idx & 63; float a = 0.f;
#pragma unroll 8
                for (int m = 0; m < 64; ++m) { const int ti = (c * m - (part ? 16 : 0)) & 63; a += ctab[ti] * FW[m * 64 + e]; }
                Mf[idx] = a * (1.0f / 512.0f); }
            __syncthreads();
#pragma unroll 1
            for (int kci = 0; kci < 4; ++kci) { const int kc = kc4 * 4 + kci; asm volatile("" ::: "memory");
            const int k = kc * 128 + (tid & 127), eg = tid >> 7;
            const float* row = p.w_in + ((size_t)l * DM + k) * INW + ZW + g * 64;
            float a[16];
#pragma unroll
            for (int j = 0; j < 16; ++j) a[j] = 0.f;
            f32x4 rw[16];
#pragma unroll
            for (int c4 = 0; c4 < 16; ++c4) rw[c4] = *(const f32x4*)(row + 4 * c4);
#pragma unroll
            for (int c4 = 0; c4 < 16; ++c4)
#pragma unroll
                for (int cc = 0; cc < 4; ++cc) { const float wv = rw[c4][cc]; const LAS f32x4* mp = (const LAS f32x4*)(Mf + (4 * c4 + cc) * 64 + eg * 16);
#pragma unroll
                    for (int j4 = 0; j4 < 4; ++j4) { const f32x4 mv = mp[j4]; a[4 * j4 + 0] += wv * mv[0]; a[4 * j4 + 1] += wv * mv[1]; a[4 * j4 + 2] += wv * mv[2]; a[4 * j4 + 3] += wv * mv[3]; } }
            bf16_t* wt = (bf16_t*)(ws + WS_WF + l * SZ_WF);
#pragma unroll
            for (int j = 0; j < 16; ++j) wt[(size_t)(part * 512 + g * 64 + eg * 16 + j) * DM + k] = (bf16_t)f2bf(a[j]);
            }
        }
    }
    {
        bf16_t* dft = (bf16_t*)(ws + WS_DFT);
        LAS float* ct = (LAS float*)(lds + 65536);
        __syncthreads();
        for (int i = tid; i < 4096; i += NTHREADS) ct[i] = cospif((float)i * (1.0f / 2048.0f));
        __syncthreads();
        const int gt = bid * NTHREADS + tid, NGT = gridDim.x * NTHREADS;
        for (int it = gt; it < 2048 * 1024; it += NGT) {
            const int k = it >> 10, s0 = (it & 1023) * 8, part = s0 >> 12, sb = s0 & 4095, sh = part ? 1024 : 0;
            float v[8];
#pragma unroll
            for (int j = 0; j < 8; ++j) v[j] = ct[(k * (sb + j) - sh) & 4095];
            u32x4 o; o.x = pk2(v[0], v[1]); o.y = pk2(v[2], v[3]); o.z = pk2(v[4], v[5]); o.w = pk2(v[6], v[7]);
            *(u32x4*)(dft + (size_t)k * 8192 + s0) = o;
        }
        __syncthreads();
    }
    {
        float* tab = (float*)(ws + WS_TAB);
        const int gt = bid * NTHREADS + tid;
        if (gt < 16 * 3 * 129) { const int h = gt / 387, r = gt % 387, pp = r / 129, j = r % 129 - 64; const int d = pp == 0 ? 1 : (pp == 1 ? 4 : 16);
            tab[(h * 3 + pp) * 132 + j + 64] = p.rel_bias[t5_bucket(d * j) * 16 + h]; }
    }
}

template <bool OUT_F32, bool IN_BF16>
__device__ __forceinline__ void phase_rmsnorm(const void* Xv, const float* gain, void* out) {
    const float* X = (const float*)Xv; const bf16_t* Xb = (const bf16_t*)Xv;
    const int tid = opaque_tid(), lane = tid & 63, wave = tid >> 6; const int bid = opaque_bid();
    const int gw = bid * NWAVES + wave, NGW = gridDim.x * NWAVES;
    f32x4 g[8];
#pragma unroll
    for (int j = 0; j < 8; ++j) g[j] = *(const f32x4*)(gain + 4 * lane + 256 * j);
    constexpr int RPT = 4;
    for (int m0 = gw; m0 < NTOK; m0 += RPT * NGW) {
        f32x4 v[RPT][8]; u32x2 t[RPT][8];
#pragma unroll
        for (int r = 0; r < RPT; ++r) { const int mr = m0 + r * NGW, mc = mr < NTOK ? mr : m0;
#pragma unroll
            for (int j = 0; j < 8; ++j) { if (IN_BF16) t[r][j] = ((const u32x2*)(Xb + (size_t)mc * DM) + lane)[64 * j]; else v[r][j] = ((const f32x4*)(X + (size_t)mc * DM) + lane)[64 * j]; } }
        float rs[RPT];
#pragma unroll
        for (int r = 0; r < RPT; ++r) { float sq = 0.f;
#pragma unroll
            for (int j = 0; j < 8; ++j) { if (IN_BF16) v[r][j] = (f32x4){bflo(t[r][j].x), bfhi(t[r][j].x), bflo(t[r][j].y), bfhi(t[r][j].y)};
                sq += (v[r][j].x * v[r][j].x + v[r][j].y * v[r][j].y) + (v[r][j].z * v[r][j].z + v[r][j].w * v[r][j].w); }
            rs[r] = 1.0f / sqrtf(wave_sum(sq) * (1.0f / DM) + EPS); }
#pragma unroll
        for (int r = 0; r < RPT; ++r) { const int m = m0 + r * NGW; if (m >= NTOK) continue;
            if (OUT_F32) { f32x4* o = (f32x4*)((float*)out + (size_t)m * DM) + lane;
#pragma unroll
                for (int j = 0; j < 8; ++j) o[64 * j] = v[r][j] * rs[r] * g[j];
            } else { u32x2* o = (u32x2*)((bf16_t*)out + (size_t)m * DM) + lane;
#pragma unroll
                for (int j = 0; j < 8; ++j) { const f32x4 y = v[r][j] * rs[r] * g[j]; u32x2 w; w.x = pk2(y.x, y.y); w.y = pk2(y.z, y.w); o[64 * j] = w; } } }
    }
}

constexpr int VROW = 144;
__device__ __forceinline__ s16x4 tr_read(const LAS unsigned char* p) { return __builtin_bit_cast(s16x4, __builtin_amdgcn_ds_read_tr16_b64_v4i16((LAS s16x4*)p)); }

__device__ __forceinline__ void phase_gmlp(const Params& p, int l, LAS unsigned char* lds) {
    const int tid = opaque_tid(), lane = tid & 63, wave = tid >> 6, fr = lane & 15, g = lane >> 4; const int bid = opaque_bid();
    const bf16_t* Z = (const bf16_t*)(p.ws + WS_Z); bf16_t* AO = (bf16_t*)(p.ws + WS_AO);
    const bool deal = (gridDim.x == 256);
    for (int ui = 0; ui < (deal ? (bid >= 128 ? 4 : 0) : (512 - bid + (int)gridDim.x - 1) / (int)gridDim.x); ++ui) { const int unit = deal ? (bid - 128) + 128 * ui : bid + ui * (int)gridDim.x; if (unit >= 512) break;
        const int h = unit & 7, ch = (unit >> 3) & 31, b = unit >> 8;
        const size_t row0 = (size_t)b * SEQ + ch * 128;
        u32x4 vch[2];
#pragma unroll
        for (int i = 0; i < 2; ++i) { const int cidx = tid + i * NTHREADS, r = cidx >> 3, c8 = cidx & 7; vch[i] = *(const u32x4*)(Z + (row0 + r) * ZW + 512 + h * 64 + c8 * 8); }
        const float* wsr = p.gmlp_ws + (((size_t)l * 8 + h) * 128 + wave * 16 + fr) * 128 + 8 * g;
        f32x4 a0[4], a1[4];
#pragma unroll
        for (int ks = 0; ks < 4; ++ks) { a0[ks] = *(const f32x4*)(wsr + 32 * ks); a1[ks] = *(const f32x4*)(wsr + 32 * ks + 4); }
        const f32x4 bias4 = *(const f32x4*)(p.gmlp_b + ((size_t)l * 8 + h) * 128 + wave * 16 + 4 * g);
        bf16_t uraw[4][4];
#pragma unroll
        for (int dt = 0; dt < 4; ++dt)
#pragma unroll
            for (int e = 0; e < 4; ++e) uraw[dt][e] = Z[(row0 + wave * 16 + 4 * g + e) * ZW + h * 64 + 16 * dt + fr];
        __syncthreads();
#pragma unroll
        for (int i = 0; i < 2; ++i) { const int cidx = tid + i * NTHREADS, r = cidx >> 3, c8 = cidx & 7;
            float t8[8]; unpack8(vch[i], t8);
            const f32x2 g0 = pg8::gelu_pk((f32x2){t8[0], t8[1]}), g1 = pg8::gelu_pk((f32x2){t8[2], t8[3]}), g2 = pg8::gelu_pk((f32x2){t8[4], t8[5]}), g3 = pg8::gelu_pk((f32x2){t8[6], t8[7]});
            u32x4 w; w.x = pk2(g0.x, g0.y); w.y = pk2(g1.x, g1.y); w.z = pk2(g2.x, g2.y); w.w = pk2(g3.x, g3.y);
            *(LAS u32x4*)(lds + r * VROW + c8 * 16) = w; }
        __syncthreads();
        bf16x8 af[4];
#pragma unroll
        for (int ks = 0; ks < 4; ++ks) { u32x4 w; w.x = pk2(a0[ks].x, a0[ks].y); w.y = pk2(a0[ks].z, a0[ks].w); w.z = pk2(a1[ks].x, a1[ks].y); w.w = pk2(a1[ks].z, a1[ks].w); af[ks] = __builtin_bit_cast(bf16x8, w); }
        const int q = (lane & 15) >> 2, pp = lane & 3;
        float ug[4][4];
#pragma unroll
        for (int dt = 0; dt < 4; ++dt) { const f32x2 a = pg8::gelu_pk((f32x2){bflo((unsigned)uraw[dt][0]), bflo((unsigned)uraw[dt][1])}), b2 = pg8::gelu_pk((f32x2){bflo((unsigned)uraw[dt][2]), bflo((unsigned)uraw[dt][3])});
            ug[dt][0] = a.x; ug[dt][1] = a.y; ug[dt][2] = b2.x; ug[dt][3] = b2.y; }
#pragma unroll
        for (int dt = 0; dt < 4; ++dt) {
            f32x4 acc = (f32x4){0.f, 0.f, 0.f, 0.f};
#pragma unroll
            for (int ks = 0; ks < 4; ++ks) {
                const LAS unsigned char* base = lds + (32 * ks + 8 * g + q) * VROW + (16 * dt + 4 * pp) * 2;
                const s16x4 lo = tr_read(base), hi = tr_read(base + 4 * VROW);
                const bf16x8 bfr = (bf16x8){lo[0], lo[1], lo[2], lo[3], hi[0], hi[1], hi[2], hi[3]};
                acc = __builtin_amdgcn_mfma_f32_16x16x32_bf16(af[ks], bfr, acc, 0, 0, 0);
            }
#pragma unroll
            for (int e = 0; e < 4; ++e) { const size_t tok = row0 + wave * 16 + 4 * g + e; const int col = h * 64 + 16 * dt + fr;
                const float uu = ug[dt][e];
                AO[tok * 512 + col] = (bf16_t)f2bf(uu * (acc[e] + bias4[e])); }
        }
    }
}

constexpr int ATT_TILE = 272 * VROW;
__device__ __forceinline__ void phase_attn(const Params& p, LAS unsigned char* lds) {
    const int tid = opaque_tid(), lane = tid & 63, wave = tid >> 6, qi = lane & 15, g = lane >> 4; const int bid = opaque_bid();
    const bf16_t* Z = (const bf16_t*)(p.ws + WS_Z); bf16_t* BO = (bf16_t*)(p.ws + WS_BO); float* LSE = (float*)(p.ws + WS_LSE);
    const float* TAB = (const float*)(p.ws + WS_TAB);
    LAS unsigned char* kl = lds; LAS unsigned char* vl = lds + ATT_TILE; LAS float* tabl = (LAS float*)(lds + 2 * ATT_TILE);
    constexpr float L2E = 1.4426950408889634f;
    constexpr int NJOB = 3072;
    __syncthreads();
    if (tid < 288) { const int which = tid / 144, off = tid % 144; unsigned z0; asm volatile("v_mov_b32 %0, 0" : "=v"(z0)); *(LAS u32x4*)(lds + which * ATT_TILE + 256 * VROW + off * 16) = (u32x4){z0, z0, z0, z0}; }
    u32x4 pre[8]; bf16x8 qpre[2]; float tabv = 0.f; unsigned okm = 0u;
#define ATT_DECODE(j, pp_, b_, h_, cls_, T_, lg_) do { pp_ = (j) >> 10; const int r_ = (j) & 1023, bh_ = r_ >> 5, rr_ = r_ & 31; lg_ = 2 * pp_; b_ = bh_ >> 4; h_ = bh_ & 15; cls_ = rr_ >> (5 - lg_); T_ = rr_ & ((32 >> lg_) - 1); } while (0)
#define ATT_PREFETCH(j) do { int pp_, b_, h_, cls_, T_, lg_; ATT_DECODE(j, pp_, b_, h_, cls_, T_, lg_); const bf16_t* Zb = Z + (size_t)b_ * SEQ * ZW + h_ * 64; const int Sd = SEQ >> lg_; okm = 0u; \
        _Pragma("unroll") for (int i = 0; i < 8; ++i) { const int idx = tid + 512 * (i & 3), row = idx >> 3, ch = idx & 7, u = 128 * T_ - 64 + row; const bool ok = (u >= 0) && (u < Sd); const int pos = cls_ + ((ok ? u : 0) << lg_); \
            okm |= ok ? (1u << i) : 0u; pre[i] = *(const u32x4*)(Zb + (size_t)pos * ZW + 2048 + (i >> 2) * 1024 + ch * 8); } \
        { const int qpos = cls_ + ((128 * T_ + 16 * wave + qi) << lg_); const bf16_t* qp = Zb + (size_t)qpos * ZW + 1024 + 16 * g; qpre[0] = *(const bf16x8*)qp; qpre[1] = *(const bf16x8*)(qp + 8); } \
        tabv = TAB[(h_ * 3 + pp_) * 132 + ((tid >= 16 && tid < 145) ? tid - 16 : 0)]; } while (0)
    const bool deal = (gridDim.x == 256);
    const int n_mine = deal ? (bid < 128 ? ATT_NA : 24 - ATT_NA) : (bid < NJOB ? (NJOB - bid + (int)gridDim.x - 1) / (int)gridDim.x : 0);
    const int vb = ((bid & 127) & 7) * 16 + ((bid & 127) >> 3);
#define ATT_JOB(idx) (deal ? (bid < 128 ? (idx) * 128 + vb : 128 * ATT_NA + (idx) * 128 + vb) : (bid + (idx) * (int)gridDim.x))
    if (n_mine > 0) ATT_PREFETCH(ATT_JOB(0));
    for (int jidx = 0; jidx < n_mine; ++jidx) { const int job = ATT_JOB(jidx);
        int pp, b, h, cls, T, lg; ATT_DECODE(job, pp, b, h, cls, T, lg);
        __syncthreads();
#pragma unroll
        for (int i = 0; i < 8; ++i) { const int idx = tid + 512 * (i & 3), row = idx >> 3, ch = idx & 7; *(LAS u32x4*)(lds + (i >> 2) * ATT_TILE + row * VROW + ch * 16) = ((okm >> i) & 1u) ? pre[i] : (u32x4){0u, 0u, 0u, 0u}; }
        if (tid < 160) tabl[tid] = (tid >= 16 && tid < 145) ? tabv * L2E : 0.f;
        const bf16x8 q0 = qpre[0], q1 = qpre[1];
        __syncthreads();
        if (jidx + 1 < n_mine) ATT_PREFETCH(ATT_JOB(jidx + 1));
        const int rowbase = 16 * wave, Sd = SEQ >> lg;
        f32x4 s[9];
        const LAS float* tb = tabl + (16 + 4 * g - qi);
        float tv[9][4];
        {
            bf16x8 kfr[9][2];
#define ATT_KLD(t) do { const LAS unsigned char* kp = kl + (rowbase + 16 * (t) + qi) * VROW + 32 * g; kfr[t][0] = *(const LAS bf16x8*)kp; kfr[t][1] = *(const LAS bf16x8*)(kp + 16); } while (0)
            ATT_KLD(0); ATT_KLD(1); ATT_KLD(2);
            __builtin_amdgcn_sched_barrier(0);
#pragma unroll
            for (int t = 0; t < 9; ++t) {
                if (t + 3 < 9) ATT_KLD(t + 3);
#pragma unroll
                for (int e = 0; e < 4; ++e) tv[t][e] = tb[16 * t + e];
                f32x4 a = (f32x4){0.f, 0.f, 0.f, 0.f};
                a = __builtin_amdgcn_mfma_f32_16x16x32_bf16(kfr[t][0], q0, a, 0, 0, 0); a = __builtin_amdgcn_mfma_f32_16x16x32_bf16(kfr[t][1], q1, a, 0, 0, 0); s[t] = a;
                __builtin_amdgcn_sched_barrier(0);
            }
#undef ATT_KLD
        }
        const int q4 = (lane & 15) >> 2, p4 = lane & 3;
        s16x4 vlo[2][4], vhi[2][4];
#define ATT_VLD(kb, slot) do { _Pragma("unroll") for (int dt = 0; dt < 4; ++dt) { const LAS unsigned char* base = vl + (rowbase + 32 * (kb) + 4 * g + q4) * VROW + (16 * p4 + 4 * dt) * 2; \
            vlo[slot][dt] = tr_read(base); vhi[slot][dt] = tr_read(base + 16 * VROW); } } while (0)
        ATT_VLD(0, 0);
        __builtin_amdgcn_sched_barrier(0);
        float mx = -1e30f;
        const int ukey0 = 128 * T - 64 + rowbase + 4 * g;
#pragma unroll
        for (int t = 0; t < 9; ++t)
#pragma unroll
            for (int e = 0; e < 4; ++e) {
                bool valid = (unsigned)(ukey0 + 16 * t + e) < (unsigned)Sd;
                if (t == 0) valid = valid && (4 * g + e >= qi);
                if (t == 8) valid = valid && (4 * g + e <= qi);
                const float xr = s[t][e] * (0.125f * L2E) + tv[t][e];
                const float xv = valid ? xr : -1e30f; s[t][e] = xv; mx = fmaxf(mx, xv); }
        mx = fmaxf(mx, __shfl_xor(mx, 16)); mx = fmaxf(mx, __shfl_xor(mx, 32));
        float lsum = 0.f;
#pragma unroll
        for (int t = 0; t < 9; ++t)
#pragma unroll
            for (int e = 0; e < 4; ++e) { const float pv = __builtin_amdgcn_exp2f(s[t][e] - mx); s[t][e] = pv; lsum += pv; }
        lsum += __shfl_xor(lsum, 16); lsum += __shfl_xor(lsum, 32);
        f32x4 o[4];
#pragma unroll
        for (int dt = 0; dt < 4; ++dt) o[dt] = (f32x4){0.f, 0.f, 0.f, 0.f};
        __builtin_amdgcn_sched_barrier(0);
#pragma unroll
        for (int kb = 0; kb < 5; ++kb) {
            if (kb + 1 < 5) ATT_VLD(kb + 1, (kb + 1) & 1);
            u32x4 pw; pw.x = pk2(s[2 * kb][0], s[2 * kb][1]); pw.y = pk2(s[2 * kb][2], s[2 * kb][3]);
            if (kb < 4) { pw.z = pk2(s[2 * kb + 1][0], s[2 * kb + 1][1]); pw.w = pk2(s[2 * kb + 1][2], s[2 * kb + 1][3]); } else { pw.z = 0u; pw.w = 0u; }
            const bf16x8 pf = __builtin_bit_cast(bf16x8, pw);
#pragma unroll
            for (int dt = 0; dt < 4; ++dt) {
                const s16x4 lo = vlo[kb & 1][dt], hi = vhi[kb & 1][dt];
                const bf16x8 vf = (bf16x8){lo[0], lo[1], lo[2], lo[3], hi[0], hi[1], hi[2], hi[3]};
                o[dt] = __builtin_amdgcn_mfma_f32_16x16x32_bf16(vf, pf, o[dt], 0, 0, 0);
            }
            __builtin_amdgcn_sched_barrier(0);
        }
#undef ATT_VLD
        const float inv = 1.0f / lsum;
        u32x4 w0, w1;
        w0.x = pk2(o[0][0] * inv, o[0][1] * inv); w0.y = pk2(o[0][2] * inv, o[0][3] * inv); w0.z = pk2(o[1][0] * inv, o[1][1] * inv); w0.w = pk2(o[1][2] * inv, o[1][3] * inv);
        w1.x = pk2(o[2][0] * inv, o[2][1] * inv); w1.y = pk2(o[2][2] * inv, o[2][3] * inv); w1.z = pk2(o[3][0] * inv, o[3][1] * inv); w1.w = pk2(o[3][2] * inv, o[3][3] * inv);
        const size_t tok = (size_t)b * SEQ + cls + ((128 * T + 16 * wave + qi) << lg);
        bf16_t* op = BO + ((size_t)pp * NTOK + tok) * 1024 + h * 64 + 16 * g;
        *(u32x4*)op = w0; *(u32x4*)(op + 8) = w1;
        if (g == 0) LSE[((size_t)pp * NTOK + tok) * 16 + h] = mx + __builtin_amdgcn_logf(lsum);
    }
#undef ATT_DECODE
#undef ATT_PREFETCH
#undef ATT_JOB
}

__device__ __forceinline__ void phase_r2048(const Params& p) {
    const int tid = opaque_tid(), lane = tid & 63, wave = tid >> 6; const int bid = opaque_bid();
    const bf16_t* T = (const bf16_t*)(p.ws + WS_T); float* R = (float*)(p.ws + WS_R2048);
    const bool deal = (gridDim.x == 256);
    const int gw = deal ? (bid - 128) * NWAVES + wave : bid * NWAVES + wave, NGW = deal ? 128 * NWAVES : (int)gridDim.x * NWAVES;
    if (deal && bid < 128) return;
    for (int job = gw; job < 1024; job += NGW) {
        const u32x4* tp = (const u32x4*)(T + (size_t)job * 8192) + lane; float acc = 0.f;
#pragma unroll
        for (int j = 0; j < 8; ++j) { float v[8]; unpack8(tp[64 * j], v); acc += ((v[0] - v[1]) + (v[2] - v[3])) + ((v[4] - v[5]) + (v[6] - v[7])); }
        acc = wave_sum(acc);
        if (lane == 0) R[job] = acc;
    }
}

__device__ __forceinline__ void phase_mixnorm(const Params& p, int l) {
    const int tid = opaque_tid(), lane = tid & 63, wave = tid >> 6; const int bid = opaque_bid();
    const int gw = bid * NWAVES + wave, NGW = gridDim.x * NWAVES;
    const bf16_t* __restrict__ AO = (const bf16_t*)(p.ws + WS_AO); const bf16_t* __restrict__ BO = (const bf16_t*)(p.ws + WS_BO); const float* __restrict__ CP = (const float*)(p.ws + WS_CP);
    bf16_t* __restrict__ MIX = (bf16_t*)(p.ws + WS_MIX);
    const float* __restrict__ gn = p.mix_gain + (size_t)l * DM;
#pragma unroll 4
    for (int m = gw; m < NTOK; m += NGW) {
        float a[8], bb[16], c[8];
        { const u32x4 w = *(const u32x4*)(AO + (size_t)m * 512 + lane * 8); a[0] = bflo(w.x); a[1] = bfhi(w.x); a[2] = bflo(w.y); a[3] = bfhi(w.y); a[4] = bflo(w.z); a[5] = bfhi(w.z); a[6] = bflo(w.w); a[7] = bfhi(w.w); }
        { const float* __restrict__ LSE = (const float*)(p.ws + WS_LSE); const int head = lane >> 2;
            const float l0 = LSE[((size_t)0 * NTOK + m) * 16 + head], l1 = LSE[((size_t)1 * NTOK + m) * 16 + head], l2 = LSE[((size_t)2 * NTOK + m) * 16 + head];
            const float lm = fmaxf(l0, fmaxf(l1, l2)); float wp[3] = {__builtin_amdgcn_exp2f(l0 - lm), __builtin_amdgcn_exp2f(l1 - lm), __builtin_amdgcn_exp2f(l2 - lm)};
            const float wi = 1.0f / (wp[0] + wp[1] + wp[2]);
#pragma unroll
            for (int j = 0; j < 16; ++j) bb[j] = 0.f;
#pragma unroll
            for (int pp = 0; pp < 3; ++pp) { const float wgt = wp[pp] * wi;
#pragma unroll
                for (int i = 0; i < 2; ++i) { const u32x4 w = *(const u32x4*)(BO + ((size_t)pp * NTOK + m) * 1024 + lane * 16 + i * 8); float t8[8]; unpack8(w, t8);
#pragma unroll
                    for (int j = 0; j < 8; ++j) bb[8 * i + j] += wgt * t8[j]; } } }
#pragma unroll
        for (int j = 0; j < 8; ++j) c[j] = 0.f;
        { const int b = m >> 12, k = m & 4095, kk = k < 2048 ? k : 4096 - k; const float sg = k < 2048 ? -1.0f : 1.0f;
          if (k == 2048) { const float* rp = (const float*)(p.ws + WS_R2048) + b * 512 + lane * 8; const f32x4 c0 = *(const f32x4*)rp, c1 = *(const f32x4*)(rp + 4);
              c[0] = c0.x; c[1] = c0.y; c[2] = c0.z; c[3] = c0.w; c[4] = c1.x; c[5] = c1.y; c[6] = c1.z; c[7] = c1.w; }
          else {
#pragma unroll
              for (int ks = 0; ks < 4; ++ks) { const bf16_t* cp = (const bf16_t*)CP + (((size_t)ks * 2 + b) * 2048 + kk) * 512 + lane * 8; float t8[8]; unpack8(*(const u32x4*)cp, t8); const float w = ks < 2 ? 1.0f : sg;
#pragma unroll
                  for (int j = 0; j < 8; ++j) c[j] += w * t8[j]; } } }
        float sa = 0.f, sb = 0.f, sc = 0.f;
#pragma unroll
        for (int j = 0; j < 8; ++j) { sa += a[j] * a[j]; sc += c[j] * c[j]; }
#pragma unroll
        for (int j = 0; j < 16; ++j) sb += bb[j] * bb[j];
        const float ra = 1.0f / sqrtf(wave_sum(sa) * (1.0f / 512.0f) + EPS), rb = 1.0f / sqrtf(wave_sum(sb) * (1.0f / 1024.0f) + EPS), rc = 1.0f / sqrtf(wave_sum(sc) * (1.0f / 512.0f) + EPS);
        bf16_t* o = MIX + (size_t)m * DM;
        { const float* gp = gn + lane * 8; u32x4 w; w.x = pk2(a[0] * ra * gp[0], a[1] * ra * gp[1]); w.y = pk2(a[2] * ra * gp[2], a[3] * ra * gp[3]); w.z = pk2(a[4] * ra * gp[4], a[5] * ra * gp[5]); w.w = pk2(a[6] * ra * gp[6], a[7] * ra * gp[7]);
            *(u32x4*)(o + lane * 8) = w; }
#pragma unroll
        for (int i = 0; i < 2; ++i) { const float* gp = gn + 512 + lane * 16 + i * 8; const float* v = bb + 8 * i; u32x4 w;
            w.x = pk2(v[0] * rb * gp[0], v[1] * rb * gp[1]); w.y = pk2(v[2] * rb * gp[2], v[3] * rb * gp[3]); w.z = pk2(v[4] * rb * gp[4], v[5] * rb * gp[5]); w.w = pk2(v[6] * rb * gp[6], v[7] * rb * gp[7]);
            *(u32x4*)(o + 512 + lane * 16 + i * 8) = w; }
        { const float* gp = gn + 1536 + lane * 8; u32x4 w; w.x = pk2(c[0] * rc * gp[0], c[1] * rc * gp[1]); w.y = pk2(c[2] * rc * gp[2], c[3] * rc * gp[3]); w.z = pk2(c[4] * rc * gp[4], c[5] * rc * gp[5]); w.w = pk2(c[6] * rc * gp[6], c[7] * rc * gp[7]);
            *(u32x4*)(o + 1536 + lane * 8) = w; }
    }
}

__device__ __forceinline__ void phase_convgate(const Params& p, int l) {
    const int tid = opaque_tid(), lane = tid & 63, wave = tid >> 6; const int bid = opaque_bid();
    const int gw = bid * NWAVES + wave, NGW = gridDim.x * NWAVES;
    const bf16_t* H = (const bf16_t*)(p.ws + WS_H); bf16_t* ACT = (bf16_t*)(p.ws + WS_ACT);
    const float* cw = p.conv_w + (size_t)l * 3 * DFF2; const float* cb = p.conv_b + (size_t)l * DFF2;
    for (int it = gw; it < 11 * 1024; it += NGW) {
        const int cc = it % 11, strip = it / 11, col = cc * 512 + lane * 8, t0 = strip * 8;
        u32x4 gr[10], ur[10];
#pragma unroll
        for (int i = 0; i < 10; ++i) { int t = t0 - 1 + i; t = t < 0 ? 0 : (t > NTOK - 1 ? NTOK - 1 : t);
            gr[i] = *(const u32x4*)(H + (size_t)t * DFF2 + col); ur[i] = *(const u32x4*)(H + (size_t)t * DFF2 + DFF + col); }
        float wg[3][8], wu[3][8], bg[8], bu[8];
#pragma unroll
        for (int k = 0; k < 3; ++k) { const f32x4 a0 = *(const f32x4*)(cw + k * DFF2 + col), a1 = *(const f32x4*)(cw + k * DFF2 + col + 4), b0 = *(const f32x4*)(cw + k * DFF2 + DFF + col), b1 = *(const f32x4*)(cw + k * DFF2 + DFF + col + 4);
#pragma unroll
            for (int j = 0; j < 4; ++j) { wg[k][j] = a0[j]; wg[k][4 + j] = a1[j]; wu[k][j] = b0[j]; wu[k][4 + j] = b1[j]; } }
        { const f32x4 a0 = *(const f32x4*)(cb + col), a1 = *(const f32x4*)(cb + col + 4), b0 = *(const f32x4*)(cb + DFF + col), b1 = *(const f32x4*)(cb + DFF + col + 4);
#pragma unroll
            for (int j = 0; j < 4; ++j) { bg[j] = a0[j]; bg[4 + j] = a1[j]; bu[j] = b0[j]; bu[4 + j] = b1[j]; } }
        const bool first = (t0 & (SEQ - 1)) == 0, lastr = ((t0 + 8) & (SEQ - 1)) == 0;
        float gp[8], gc[8], gn[8], up[8], uc[8], un[8];
        unpack8(gr[0], gp); unpack8(ur[0], up); unpack8(gr[1], gc); unpack8(ur[1], uc);
        if (first) {
#pragma unroll
            for (int j = 0; j < 8; ++j) { gp[j] = 0.f; up[j] = 0.f; } }
#pragma unroll
        for (int i = 0; i < 8; ++i) {
            unpack8(gr[i + 2], gn); unpack8(ur[i + 2], un);
            if (i == 7 && lastr) {
#pragma unroll
                for (int j = 0; j < 8; ++j) { gn[j] = 0.f; un[j] = 0.f; } }
            float r[8];
#pragma unroll
            for (int j = 0; j < 8; ++j) { const float G = gp[j] * wg[0][j] + gc[j] * wg[1][j] + gn[j] * wg[2][j] + bg[j]; const float U = up[j] * wu[0][j] + uc[j] * wu[1][j] + un[j] * wu[2][j] + bu[j];
                r[j] = G * __builtin_amdgcn_rcpf(1.0f + __expf(-G)) * U; gp[j] = gc[j]; gc[j] = gn[j]; up[j] = uc[j]; uc[j] = un[j]; }
            u32x4 w; w.x = pk2(r[0], r[1]); w.y = pk2(r[2], r[3]); w.z = pk2(r[4], r[5]); w.w = pk2(r[6], r[7]);
            *(u32x4*)(ACT + (size_t)(t0 + i) * DFF + col) = w;
        }
    }
}

constexpr int NPHASE = 2 + 8 * DEPTH;
__global__ void __launch_bounds__(NTHREADS) fwd_megakernel(Params p) {
    extern __shared__ __attribute__((aligned(16))) unsigned char lds_raw[];
    LAS unsigned char* lds = (LAS unsigned char*)lds_raw;
    unsigned char* ws = p.ws;
    bf16_t* XB = (bf16_t*)(ws + WS_X);
    volatile LAS unsigned* bst = (volatile LAS unsigned*)(lds + 143360);
    if (threadIdx.x < 2) bst[threadIdx.x] = 0u;
    __syncthreads();
    const XcdBarrier gbar = xcd_barrier_post((unsigned*)(ws + WS_CTL), bst);
    for (int ph = p.ph_lo; ph < p.ph_hi; ++ph) {
        bool need_bar = true;
        if (ph == 0) { phase_prep(p, lds); phase_rmsnorm<false, false>(p.x, p.norm_mix, ws + WS_XN); }
        else if (ph == NPHASE - 1) phase_rmsnorm<true, true>(XB, p.final_norm, p.out);
        else {
            const int l = (ph - 1) / 8, k = (ph - 1) % 8;
            Sched S; S.G = gridDim.x; S.c = opaque_bid(); S.kind = -1; S.A0 = S.B0 = S.A1 = S.B1 = nullptr; S.O0 = S.O1 = nullptr; S.R0 = nullptr; S.r32 = 0; S.nM = S.nN = 0; S.K = DM;
            int gK = DM, lda = DM, ldb = DM; int epi = 0;
            if (k == 0) { if (l > 0) phase_rmsnorm<false, true>(XB, p.norm_mix + (size_t)l * DM, ws + WS_XN); else need_bar = false; }
            else if (k == 1) { S.kind = 0; S.A0 = (const char*)(ws + WS_XN); S.B0 = (const char*)(ws + WS_WIN + l * SZ_WIN); S.O0 = (char*)(ws + WS_Z);
                S.A1 = (const char*)(ws + WS_WF + l * SZ_WF); S.B1 = (const char*)(ws + WS_XN); S.O1 = (char*)(ws + WS_T); }
            else if (k == 2) { S.kind = 2; S.A0 = (const char*)(ws + WS_DFT); S.B0 = (const char*)(ws + WS_T); S.O0 = (char*)(ws + WS_CP); lda = 8192; ldb = 8192; epi = 0; }
            else if (k == 3) phase_mixnorm(p, l);
            else if (k == 4) { S.kind = 3; S.A0 = (const char*)(ws + WS_MIX); S.B0 = (const char*)(ws + WS_WOUT + l * SZ_WOUT); S.O0 = (char*)XB; S.R0 = (l == 0) ? p.x : (const float*)XB; S.r32 = (l == 0) ? 1 : 0; S.nM = 32; S.nN = 8; epi = 1; }
            else if (k == 5) phase_rmsnorm<false, true>(XB, p.norm_ffn + (size_t)l * DM, ws + WS_XN);
            else if (k == 6) { S.kind = 5; S.A0 = (const char*)(ws + WS_XN); S.B0 = (const char*)(ws + WS_WUP + l * SZ_WUP); S.O0 = (char*)(ws + WS_ACT); S.R0 = p.conv_w + (size_t)l * 3 * DFF2; epi = 2; }
            else { S.kind = 3; S.A0 = (const char*)(ws + WS_ACT); S.B0 = (const char*)(ws + WS_WDN + l * SZ_WDN); S.O0 = (char*)XB; S.R0 = (const float*)XB; S.r32 = 0; S.nM = 32; S.nN = 8; S.K = DFF; gK = DFF; lda = DFF; ldb = DFF; epi = 1; }
            if (S.kind >= 0) {
                if (epi == 0) pg8::gemm_phase<pg8::EpiBf16, Sched>(lds, gK, lda, ldb, S, pg8::EpiBf16{});
                else if (epi == 1) pg8::gemm_phase<pg8::EpiF32, Sched>(lds, gK, lda, ldb, S, pg8::EpiF32{});
                else pg8::gemm_phase<pg8::EpiConvGate, Sched>(lds, gK, lda, ldb, S, pg8::EpiConvGate{p.conv_w + (size_t)l * 3 * DFF2, p.conv_b + (size_t)l * DFF2, (LAS float*)(lds + 131072)}, DFF);
            }
            if (k == 1 && gridDim.x == 256 && S.c >= 128) { __syncthreads(); const int t_ = opaque_tid(); const int gw_ = (S.c - 128) * NWAVES + (t_ >> 6);
                transpose_range(p, lds, l, TI_IN, TI_IN + TI_OUT + TI_UP, gw_, 128 * NWAVES, t_ >> 6, t_ & 63);
                if (l + 1 < DEPTH) transpose_range(p, lds, l + 1, 0, TI_IN, gw_, 128 * NWAVES, t_ >> 6, t_ & 63); }
            if (k == 6 && gridDim.x == 256 && S.c >= 216) { __syncthreads(); const int t_ = opaque_tid();
                transpose_range(p, lds, l, TI_IN + TI_OUT + TI_UP, TI_L, (S.c - 216) * NWAVES + (t_ >> 6), 40 * NWAVES, t_ >> 6, t_ & 63); }
            if (k == 2) { __syncthreads(); phase_attn(p, lds); __syncthreads(); phase_gmlp(p, l, lds); phase_r2048(p); }
        }
        if (ph + 1 < p.ph_hi && need_bar) { if (p.ph_lo < 0) cg::this_grid().sync(); else xcd_barrier(gbar); }
    }
}

extern "C" void kernel_launch(void* const* d_in, const int* in_sizes, int n_in, void* d_out, int out_size, void* d_ws, size_t ws_size, hipStream_t stream) {
    static int grid = 0;
    if (grid == 0) {
        if (n_in != 15 || in_sizes[0] != NTOK * DM || out_size != NTOK * DM || ws_size < WS_END) { fprintf(stderr, "kernel_launch: unexpected shapes / workspace (%d inputs, in0 %d, out %d, ws %zu < %zu)\n", n_in, n_in > 0 ? in_sizes[0] : -1, out_size, ws_size, (size_t)WS_END); grid = -1; return; }
        int dev = 0, cus = 0, per_cu = 0;
        hipGetDevice(&dev); hipDeviceGetAttribute(&cus, hipDeviceAttributeMultiprocessorCount, dev);
        if (hipFuncSetAttribute((const void*)fwd_megakernel, hipFuncAttributeMaxDynamicSharedMemorySize, LDS_BYTES) != hipSuccess) { fprintf(stderr, "kernel_launch: hipFuncSetAttribute failed\n"); grid = -1; return; }
        if (hipOccupancyMaxActiveBlocksPerMultiprocessor(&per_cu, (const void*)fwd_megakernel, NTHREADS, LDS_BYTES) != hipSuccess || per_cu < 1) { fprintf(stderr, "kernel_launch: occupancy query says %d\n", per_cu); per_cu = 1; }
        (void)hipGetLastError();
        grid = cus * 1;
        if (grid <= 0) grid = 256;
    }
    if (grid < 0) return;
    if (hipMemsetAsync((unsigned char*)d_ws + WS_CTL, 0, CTL_BYTES, stream) != hipSuccess) { fprintf(stderr, "kernel_launch: memset failed\n"); return; }
    Params p{};
    p.x = (const float*)d_in[0]; p.w_in = (const float*)d_in[1]; p.gmlp_ws = (const float*)d_in[2]; p.gmlp_b = (const float*)d_in[3]; p.fnet_w = (const float*)d_in[4];
    p.mix_gain = (const float*)d_in[5]; p.w_out = (const float*)d_in[6]; p.norm_mix = (const float*)d_in[7]; p.norm_ffn = (const float*)d_in[8]; p.ffn_up = (const float*)d_in[9];
    p.conv_w = (const float*)d_in[10]; p.conv_b = (const float*)d_in[11]; p.ffn_down = (const float*)d_in[12]; p.rel_bias = (const float*)d_in[13]; p.final_norm = (const float*)d_in[14];
    p.out = (float*)d_out; p.ws = (unsigned char*)d_ws;
#if MK_PER_PHASE_LAUNCH
    for (int ph = 0; ph < NPHASE; ++ph) { p.ph_lo = ph; p.ph_hi = ph + 1; hipLaunchKernelGGL(fwd_megakernel, dim3(grid), dim3(NTHREADS), LDS_BYTES, stream, p); }
#else
    p.ph_lo = 0; p.ph_hi = NPHASE;
    void* args[] = {&p};
    hipError_t e = hipLaunchCooperativeKernel((const void*)fwd_megakernel, dim3(grid), dim3(NTHREADS), args, LDS_BYTES, stream);
    if (e != hipSuccess) fprintf(stderr, "kernel_launch: cooperative launch failed: %s (grid %d)\n", hipGetErrorString(e), grid);
#endif
}
```

```cpp
#include <hip/hip_runtime.h>
#include <hip/hip_cooperative_groups.h>
#include <cstdio>
#include <cstdint>
namespace cg = cooperative_groups;

#ifndef ATT_NA
#define ATT_NA 8
#endif
#ifndef MK_PER_PHASE_LAUNCH
#define MK_PER_PHASE_LAUNCH 0
#endif

#define LAS __attribute__((address_space(3)))
typedef unsigned short bf16_t;
typedef short bf16x8 __attribute__((ext_vector_type(8)));
typedef short s16x4 __attribute__((ext_vector_type(4)));
typedef float f32x4 __attribute__((ext_vector_type(4)));
typedef float f32x2 __attribute__((ext_vector_type(2)));
typedef unsigned u32x4 __attribute__((ext_vector_type(4)));
typedef unsigned u32x2 __attribute__((ext_vector_type(2)));

constexpr int DM = 2048, SEQ = 4096, NTOK = 8192, DEPTH = 4;
constexpr int INW = 4608, ZW = 4096;
constexpr int DFF = 5632, DFF2 = 11264;
constexpr float EPS = 1e-6f;
constexpr int NTHREADS = 512, NWAVES = 8;

constexpr size_t MiB = 1u << 20;
constexpr size_t SZ_WIN = (size_t)ZW * DM * 2, SZ_WF = (size_t)1024 * DM * 2, SZ_WOUT = (size_t)DM * DM * 2, SZ_WUP = (size_t)DFF2 * DM * 2, SZ_WDN = (size_t)DM * DFF * 2;
constexpr size_t WS_WIN = 0;
constexpr size_t WS_WF = WS_WIN + DEPTH * SZ_WIN;
constexpr size_t WS_WOUT = WS_WF + DEPTH * SZ_WF;
constexpr size_t WS_WUP = WS_WOUT + DEPTH * SZ_WOUT;
constexpr size_t WS_WDN = WS_WUP + DEPTH * SZ_WUP;
constexpr size_t WS_DFT = WS_WDN + DEPTH * SZ_WDN;
constexpr size_t WS_TAB = WS_DFT + (size_t)4096 * 8192 * 2;
constexpr size_t WS_X = WS_TAB + 1 * MiB;
constexpr size_t WS_XN = WS_X + (size_t)NTOK * DM * 4;
constexpr size_t WS_Z = WS_XN + (size_t)NTOK * DM * 2;
constexpr size_t WS_T = WS_Z + (size_t)NTOK * ZW * 2;
constexpr size_t WS_CP = WS_T + (size_t)1024 * 8192 * 2;
constexpr size_t WS_AO = WS_CP + (size_t)4 * NTOK * 512 * 4;
constexpr size_t WS_BO = WS_AO + (size_t)NTOK * 512 * 2;
constexpr size_t WS_LSE = WS_BO + (size_t)3 * NTOK * 1024 * 2;
constexpr size_t WS_MIX = WS_LSE + (size_t)3 * NTOK * 16 * 4;
constexpr size_t WS_H = WS_MIX + (size_t)NTOK * DM * 2;
constexpr size_t WS_ACT = WS_H + (size_t)NTOK * DFF2 * 2;
constexpr size_t WS_CTL = WS_ACT + (size_t)NTOK * DFF * 2;
constexpr size_t CTL_BYTES = 65536;
constexpr size_t WS_R2048 = WS_CTL + CTL_BYTES;
constexpr size_t WS_END = WS_R2048 + 4096;

constexpr int LDS_BYTES = 147456;

__device__ __forceinline__ unsigned f2bf(float f) { unsigned u = __builtin_bit_cast(unsigned, f); return (u + 0x7fffu + ((u >> 16) & 1u)) >> 16; }
typedef __bf16 hwbf16x2 __attribute__((ext_vector_type(2)));
__device__ __forceinline__ unsigned pk2(float lo, float hi) { const f32x2 v = {lo, hi}; const hwbf16x2 b = __builtin_convertvector(v, hwbf16x2); return __builtin_bit_cast(unsigned, b); }
__device__ __forceinline__ float bflo(unsigned w) { return __uint_as_float(w << 16); }
__device__ __forceinline__ float bfhi(unsigned w) { return __uint_as_float(w & 0xffff0000u); }
__device__ __forceinline__ float wave_sum(float v) {
#pragma unroll
    for (int o = 1; o < 64; o <<= 1) v += __shfl_xor(v, o);
    return v;
}
#define LDS_WAIT() asm volatile("s_waitcnt lgkmcnt(0)" ::: "memory")
__device__ __forceinline__ void unpack8(const u32x4 w, float* v) { v[0] = bflo(w.x); v[1] = bfhi(w.x); v[2] = bflo(w.y); v[3] = bfhi(w.y); v[4] = bflo(w.z); v[5] = bfhi(w.z); v[6] = bflo(w.w); v[7] = bfhi(w.w); }
__device__ __forceinline__ int opaque_tid() { int t = threadIdx.x; asm volatile("" : "+v"(t)); return t; }
__device__ __forceinline__ int opaque_bid() { int t = blockIdx.x; asm volatile("" : "+s"(t)); return t; }

namespace pg8 {
constexpr int BM = 256, BK = 64, HALF = 128, HTB = HALF * BK * 2, STAGE_BYTES = 8 * HTB, NXCD = 8, WGM = 8;
__device__ __forceinline__ int lds_byte(int r, int c) { const int st = (r >> 4) * 2 + (c >> 5), rr = r & 15, cc = c & 31, ob = rr * 64 + cc * 2; return st * 1024 + (ob ^ (((ob >> 9) & 1) << 5)); }
__device__ __forceinline__ void stage_rc(int b, int& R, int& C) { const int st = b / 1024, sb = b % 1024, swz = sb ^ (((sb >> 9) & 1) << 5); R = (st >> 1) * 16 + swz / 64; C = (st & 1) * 32 + (swz % 64) / 2; }
__device__ __forceinline__ int perm32(int rho) { const int n = rho >> 4, i = rho & 15; return 8 * (i >> 2) + 4 * n + (i & 3); }

struct Unit { const char* A; const char* B; char* O; const float* R; int ldc; int flag; };

__device__ __forceinline__ unsigned cvt_pk_bf16(float lo, float hi) { unsigned r; asm volatile("v_cvt_pk_bf16_f32 %0, %1, %2" : "=v"(r) : "v"(lo), "v"(hi)); return r; }
__device__ __forceinline__ f32x2 gelu_pk(f32x2 v) {
    const f32x2 av = __builtin_elementwise_abs(v), d = av * 0.2316418882f + 1.0f;
    f32x2 t; t.x = __builtin_amdgcn_rcpf(d.x); t.y = __builtin_amdgcn_rcpf(d.y);
    f32x2 q = t * 0.5307027145f + (-0.7265760135f); q = q * t + 0.7107068705f; q = q * t + (-0.142248368f); q = q * t + 0.127414796f; q = q * t;
    const f32x2 s = (v * v) * (-0.72134752044f);
    f32x2 e; e.x = __builtin_amdgcn_exp2f(s.x); e.y = __builtin_amdgcn_exp2f(s.y);
    const f32x2 m = v * (q * e), r = v - m;
    f32x2 o; o.x = v.x < 0.f ? m.x : r.x; o.y = v.y < 0.f ? m.y : r.y; return o;
}

__device__ __forceinline__ void store16_wt(void* p, u32x4 v) { asm volatile("s_nop 1\n\tglobal_store_dwordx4 %0, %1, off sc0 sc1\n\ts_nop 2" :: "v"(p), "v"(v) : "memory"); }
struct EpiBf16 {
    static constexpr bool PERM = true;
    __device__ __forceinline__ void operator()(const f32x4 (&acc)[2][2][4][2], const Unit& u, int wr, int wc, int fr, int fq) const {
        bf16_t* base = (bf16_t*)u.O + (size_t)(wr * 64 + fr) * u.ldc + wc * 32 + 8 * fq;
        const bool act = (u.flag & 1) != 0;
#pragma unroll
        for (int ai = 0; ai < 2; ++ai)
#pragma unroll
            for (int m = 0; m < 4; ++m) { bf16_t* rowp = base + (size_t)(ai * HALF + m * 16) * u.ldc;
#pragma unroll
                for (int bj = 0; bj < 2; ++bj) { f32x4 v0 = acc[ai][bj][m][0], v1 = acc[ai][bj][m][1];
                    if (act) { f32x2 a = gelu_pk((f32x2){v0[0], v0[1]}), b = gelu_pk((f32x2){v0[2], v0[3]}), c = gelu_pk((f32x2){v1[0], v1[1]}), d = gelu_pk((f32x2){v1[2], v1[3]});
                        v0 = (f32x4){a.x, a.y, b.x, b.y}; v1 = (f32x4){c.x, c.y, d.x, d.y}; }
                    u32x4 w; w.x = cvt_pk_bf16(v0[0], v0[1]); w.y = cvt_pk_bf16(v0[2], v0[3]); w.z = cvt_pk_bf16(v1[0], v1[1]); w.w = cvt_pk_bf16(v1[2], v1[3]);
                    *(u32x4*)(rowp + bj * HALF) = w; } }
    }
};
struct EpiF32 {
    static constexpr bool PERM = true;
    __device__ __forceinline__ void operator()(const f32x4 (&acc)[2][2][4][2], const Unit& u, int wr, int wc, int fr_in, int fq_in) const {
        int tt = threadIdx.x; asm volatile("" : "+v"(tt)); const int fr = tt & 15, fq = (tt >> 4) & 3; (void)fr_in; (void)fq_in;
        const size_t off0 = (size_t)(wr * 64 + fr) * u.ldc + wc * 32 + 8 * fq;
        bf16_t* O = (bf16_t*)u.O; const bool r32 = (u.flag & 1) != 0;
        const float* R32 = u.R; const bf16_t* R16 = (const bf16_t*)u.R;
#pragma unroll
        for (int ai = 0; ai < 2; ++ai)
#pragma unroll
            for (int mh = 0; mh < 2; ++mh) {
                f32x4 rv[2][2][2];
                if (r32) {
#pragma unroll
                    for (int m2 = 0; m2 < 2; ++m2)
#pragma unroll
                        for (int bj = 0; bj < 2; ++bj)
#pragma unroll
                            for (int n = 0; n < 2; ++n) rv[m2][bj][n] = *(const f32x4*)(R32 + off0 + (size_t)(ai * HALF + (2 * mh + m2) * 16) * u.ldc + bj * HALF + 4 * n);
                } else {
                    u32x4 rb[2][2];
#pragma unroll
                    for (int m2 = 0; m2 < 2; ++m2)
#pragma unroll
                        for (int bj = 0; bj < 2; ++bj) rb[m2][bj] = *(const u32x4*)(R16 + off0 + (size_t)(ai * HALF + (2 * mh + m2) * 16) * u.ldc + bj * HALF);
#pragma unroll
                    for (int m2 = 0; m2 < 2; ++m2)
#pragma unroll
                        for (int bj = 0; bj < 2; ++bj) { const u32x4 t = rb[m2][bj]; rv[m2][bj][0] = (f32x4){bflo(t.x), bfhi(t.x), bflo(t.y), bfhi(t.y)}; rv[m2][bj][1] = (f32x4){bflo(t.z), bfhi(t.z), bflo(t.w), bfhi(t.w)}; }
                }
                asm volatile("" ::: "memory");
#pragma unroll
                for (int m2 = 0; m2 < 2; ++m2) { const int m = 2 * mh + m2; const size_t off = off0 + (size_t)(ai * HALF + m * 16) * u.ldc;
#pragma unroll
                    for (int bj = 0; bj < 2; ++bj) { const f32x4 v0 = acc[ai][bj][m][0] + rv[m2][bj][0], v1 = acc[ai][bj][m][1] + rv[m2][bj][1];
                        u32x4 w; w.x = cvt_pk_bf16(v0[0], v0[1]); w.y = cvt_pk_bf16(v0[2], v0[3]); w.z = cvt_pk_bf16(v1[0], v1[1]); w.w = cvt_pk_bf16(v1[2], v1[3]);
                        *(u32x4*)(O + off + bj * HALF) = w; } }
                asm volatile("" ::: "memory");
            }
    }
};

__device__ __forceinline__ float dpp_ror1(float v) { return __int_as_float(__builtin_amdgcn_update_dpp(0, __float_as_int(v), 0x121, 0xf, 0xf, false)); }
__device__ __forceinline__ float dpp_rol1(float v) { return __int_as_float(__builtin_amdgcn_update_dpp(0, __float_as_int(v), 0x12F, 0xf, 0xf, false)); }
struct EpiConvGate {
    static constexpr bool PERM = true;
    const float* cw; const float* cb; LAS float* xl;
    __device__ __forceinline__ void operator()(const f32x4 (&acc)[2][2][4][2], const Unit& u, int wr, int wc, int fr_in, int fq_in) const {
        LAS float* X = xl;
        LAS float* W = xl + 2048;
        int fr = fr_in, fq = fq_in, t = threadIdx.x; asm volatile("" : "+v"(fr), "+v"(fq), "+v"(t));
        const int cl = wc * 32 + 8 * fq;
        float wl[4] = {0.f, 0.f, 0.f, 0.f};
        { const int col0 = (int)(u.R - cw);
          if (t < 256) { const int bj = t >> 7, c = t & 127; const int gc = bj * DFF + col0 + c; wl[0] = cw[gc]; wl[1] = cw[DFF2 + gc]; wl[2] = cw[2 * DFF2 + gc]; wl[3] = cb[gc]; } }
#pragma unroll
        for (int ai = 0; ai < 2; ++ai) { const int Bk = 2 * ai + wr;
#pragma unroll
            for (int bj = 0; bj < 2; ++bj)
#pragma unroll
                for (int n = 0; n < 2; ++n) {
                    if (fr == 0) *(LAS f32x4*)(X + ((Bk * 2 + 0) * 2 + bj) * 128 + cl + 4 * n) = acc[ai][bj][0][n];
                    if (fr == 15) *(LAS f32x4*)(X + ((Bk * 2 + 1) * 2 + bj) * 128 + cl + 4 * n) = acc[ai][bj][3][n]; } }
        if (t < 256) { const int bj = t >> 7, c = t & 127; W[(0 * 2 + bj) * 128 + c] = wl[0]; W[(1 * 2 + bj) * 128 + c] = wl[1]; W[(2 * 2 + bj) * 128 + c] = wl[2]; W[(3 * 2 + bj) * 128 + c] = wl[3]; }
        asm volatile("s_waitcnt vmcnt(0) lgkmcnt(0)" ::: "memory"); __builtin_amdgcn_s_barrier(); asm volatile("" ::: "memory");
        const int j = u.flag;
        bf16_t* obase = (bf16_t*)u.O + cl;
#pragma unroll
        for (int n = 0; n < 2; ++n) {
            f32x4 wv[4][2];
#pragma unroll
            for (int k = 0; k < 4; ++k)
#pragma unroll
                for (int bj = 0; bj < 2; ++bj) wv[k][bj] = *(const LAS f32x4*)(W + (k * 2 + bj) * 128 + cl + 4 * n);
#pragma unroll
            for (int ai = 0; ai < 2; ++ai) { const int Bk = 2 * ai + wr;
#pragma unroll
                for (int m = 0; m < 4; ++m) {
                    const int r = 128 * ai + 64 * wr + 16 * m + fr, tb = 254 * j + r - 1;
                    f32x4 res[2];
#pragma unroll
                    for (int bj = 0; bj < 2; ++bj) {
                        const f32x4 cur = acc[ai][bj][m][n];
                        f32x4 pe, ne;
                        if (m > 0) { const f32x4 q = acc[ai][bj][m > 0 ? m - 1 : 0][n]; pe = (f32x4){dpp_ror1(q[0]), dpp_ror1(q[1]), dpp_ror1(q[2]), dpp_ror1(q[3])}; }
                        else pe = *(const LAS f32x4*)(X + (((Bk > 0 ? Bk - 1 : 0) * 2 + 1) * 2 + bj) * 128 + cl + 4 * n);
                        if (m < 3) { const f32x4 q = acc[ai][bj][m < 3 ? m + 1 : 3][n]; ne = (f32x4){dpp_rol1(q[0]), dpp_rol1(q[1]), dpp_rol1(q[2]), dpp_rol1(q[3])}; }
                        else ne = *(const LAS f32x4*)(X + (((Bk < 3 ? Bk + 1 : 3) * 2 + 0) * 2 + bj) * 128 + cl + 4 * n);
                        f32x4 pvv, nvv;
#pragma unroll
                        for (int e = 0; e < 4; ++e) {
                            float pv = __int_as_float(__builtin_amdgcn_update_dpp(__float_as_int(pe[e]), __float_as_int(cur[e]), 0x111, 0xf, 0xf, false));
                            float nv = __int_as_float(__builtin_amdgcn_update_dpp(__float_as_int(ne[e]), __float_as_int(cur[e]), 0x101, 0xf, 0xf, false));
                            if (ai == 0 && m == 0) pv = (tb == 0) ? 0.f : pv;
                            if (ai == 0 && m == 2) nv = (tb == SEQ - 1) ? 0.f : nv;
                            pvv[e] = pv; nvv[e] = nv; }
                        res[bj] = pvv * wv[0][bj] + (cur * wv[1][bj] + (nvv * wv[2][bj] + wv[3][bj]));
                    }
                    f32x4 y;
                    { const f32x4 G = res[0], t = G * -1.4426950408889634f;
                      f32x4 den; den[0] = __builtin_amdgcn_exp2f(t[0]); den[1] = __builtin_amdgcn_exp2f(t[1]); den[2] = __builtin_amdgcn_exp2f(t[2]); den[3] = __builtin_amdgcn_exp2f(t[3]);
                      den = den + 1.0f;
                      f32x4 rc; rc[0] = __builtin_amdgcn_rcpf(den[0]); rc[1] = __builtin_amdgcn_rcpf(den[1]); rc[2] = __builtin_amdgcn_rcpf(den[2]); rc[3] = __builtin_amdgcn_rcpf(den[3]);
                      y = (G * res[1]) * rc; }
                    u32x2 w; w.x = cvt_pk_bf16(y[0], y[1]); w.y = cvt_pk_bf16(y[2], y[3]);
                    if (r >= 1 && r <= 254 && tb < SEQ) *(u32x2*)(obase + (size_t)r * DFF + 4 * n) = w;
                } }
        }
    }
};

template <class Epi, class Sched>
__device__ __forceinline__ void gemm_phase(LAS unsigned char* lds, const int K, const int lda, const int ldb, const Sched& S, const Epi& E, const int bhalf_rows = 128) {
    const int tid = opaque_tid(), wid = __builtin_amdgcn_readfirstlane(tid >> 6), lane = tid & 63, wr = wid >> 2, wc = wid & 3, fr = lane & 15, fq = lane >> 4;
    const int nt = K / BK;
    unsigned voffA[2], voffB[2];
#pragma unroll
    for (int i = 0; i < 2; ++i) { int R, C; stage_rc(tid * 16 + i * 8192, R, C); const int Rb = Epi::PERM ? ((R & ~31) + perm32(R & 31)) : R;
        voffA[i] = (unsigned)(R * lda + C) * 2u; voffB[i] = (unsigned)(Rb * ldb + C) * 2u; }
    const size_t kstep = (size_t)(BK * 2);
    const size_t hstepA = (size_t)HALF * lda * 2, hstepB = (size_t)bhalf_rows * ldb * 2;
    const unsigned ldsw = (unsigned)wid * 1024u;
    const int aoff = lds_byte(wr * 64 + fr, fq * 8), boff = lds_byte(wc * 32 + fr, fq * 8);
#define PG8_SA(b, h) (((b) * 2 + (h)) * HTB)
#define PG8_SB(b, h) ((4 + (b) * 2 + (h)) * HTB)
#define PG8_STAGE(bufoff, gbase, voff) do { _Pragma("unroll") for (int _i = 0; _i < 2; ++_i) \
        __builtin_amdgcn_global_load_lds((const unsigned*)((const char*)(gbase) + (voff)[_i]), (LAS unsigned*)(lds + (bufoff) + ldsw + _i * 8192), 16, 0, 0); } while (0)
#define PG8_LDA(dst, b, h) do { _Pragma("unroll") for (int m = 0; m < 4; ++m) _Pragma("unroll") for (int k = 0; k < 2; ++k) dst[m][k] = *(const LAS bf16x8*)(lds + PG8_SA(b, h) + aoff + m * 2048 + k * 1024); } while (0)
#define PG8_LDB(dst, b, h) do { _Pragma("unroll") for (int n = 0; n < 2; ++n) _Pragma("unroll") for (int k = 0; k < 2; ++k) dst[n][k] = *(const LAS bf16x8*)(lds + PG8_SB(b, h) + boff + n * 2048 + k * 1024); } while (0)
#define PG8_MMA(ai, bj, At, Bt) do { __builtin_amdgcn_s_setprio(1); _Pragma("unroll") for (int m = 0; m < 4; ++m) _Pragma("unroll") for (int n = 0; n < 2; ++n) _Pragma("unroll") for (int k = 0; k < 2; ++k) \
        acc[ai][bj][m][n] = __builtin_amdgcn_mfma_f32_16x16x32_bf16(Bt[n][k], At[m][k], acc[ai][bj][m][n], 0, 0, 0); __builtin_amdgcn_s_setprio(0); } while (0)
#define PG8_WAIT_V(n) asm volatile("s_waitcnt vmcnt(" #n ")" ::: "memory")
#define PG8_WAIT_L(n) asm volatile("s_waitcnt lgkmcnt(" #n ")" ::: "memory")
#define PG8_BAR __builtin_amdgcn_s_barrier()
#define PG8_SCHED __builtin_amdgcn_sched_barrier(0)
    Unit cur, nxt; int ui = 0;
    if (!S.next(0, cur)) return;
    f32x4 acc[2][2][4][2];
#pragma unroll
    for (int a = 0; a < 2; ++a)
#pragma unroll
        for (int b = 0; b < 2; ++b)
#pragma unroll
            for (int m = 0; m < 4; ++m)
#pragma unroll
                for (int n = 0; n < 2; ++n) acc[a][b][m][n] = (f32x4){0.f, 0.f, 0.f, 0.f};
    bf16x8 At[4][2], B0[2][2], B1[2][2];
    const char* cA = cur.A; const char* cB = cur.B;
    PG8_STAGE(PG8_SB(0, 0), cB, voffB); PG8_STAGE(PG8_SB(0, 1), cB + hstepB, voffB); PG8_STAGE(PG8_SA(0, 0), cA, voffA); PG8_STAGE(PG8_SA(0, 1), cA + hstepA, voffA);
    if (wr == 1) PG8_BAR;
    PG8_WAIT_V(2); PG8_BAR;
    PG8_STAGE(PG8_SB(1, 0), cB + kstep, voffB); PG8_STAGE(PG8_SA(1, 0), cA + kstep, voffA); PG8_STAGE(PG8_SB(1, 1), cB + hstepB + kstep, voffB);
    PG8_WAIT_V(6); PG8_BAR;
    for (;;) {
        const bool has_next = S.next(ui + 1, nxt);
        const char* nA = has_next ? nxt.A : cA; const char* nB = has_next ? nxt.B : cB;
        for (int t = 0; t < nt; t += 2) {
            const bool last = (t == nt - 2);
            const char* a1 = cA + (size_t)(t + 1) * kstep;
            const char* a2 = last ? nA : cA + (size_t)(t + 2) * kstep; const char* b2 = last ? nB : cB + (size_t)(t + 2) * kstep;
            const char* a3 = a2 + kstep; const char* b3 = b2 + kstep;
            PG8_LDB(B0, 0, 0); PG8_LDB(B1, 0, 1); PG8_SCHED; PG8_LDA(At, 0, 0); PG8_STAGE(PG8_SA(1, 1), a1 + hstepA, voffA);
            PG8_WAIT_V(8); PG8_WAIT_L(0); PG8_BAR; PG8_MMA(0, 0, At, B0); PG8_MMA(0, 1, At, B1); PG8_BAR; PG8_SCHED;
            PG8_LDA(At, 0, 1); PG8_STAGE(PG8_SB(0, 0), b2, voffB); PG8_STAGE(PG8_SB(0, 1), b2 + hstepB, voffB); PG8_STAGE(PG8_SA(0, 0), a2, voffA);
            PG8_WAIT_V(8); PG8_WAIT_L(0); PG8_BAR; PG8_MMA(1, 0, At, B0); PG8_MMA(1, 1, At, B1); PG8_BAR; PG8_SCHED;
            PG8_LDB(B0, 1, 0); PG8_LDB(B1, 1, 1); PG8_SCHED; PG8_LDA(At, 1, 0); PG8_STAGE(PG8_SA(0, 1), a2 + hstepA, voffA);
            PG8_WAIT_V(8); PG8_WAIT_L(0); PG8_BAR; PG8_MMA(0, 0, At, B0); PG8_MMA(0, 1, At, B1); PG8_BAR; PG8_SCHED;
            PG8_LDA(At, 1, 1); PG8_STAGE(PG8_SB(1, 0), b3, voffB); PG8_STAGE(PG8_SB(1, 1), b3 + hstepB, voffB); PG8_STAGE(PG8_SA(1, 0), a3, voffA);
            PG8_WAIT_V(8); PG8_WAIT_L(0); PG8_BAR; PG8_MMA(1, 0, At, B0); PG8_MMA(1, 1, At, B1); PG8_BAR; PG8_SCHED;
        }
        if (wr == 0) PG8_BAR;
        E(acc, cur, wr, wc, fr, fq);
        if (!has_next) break;
#pragma unroll
        for (int a = 0; a < 2; ++a)
#pragma unroll
            for (int b = 0; b < 2; ++b)
#pragma unroll
                for (int m = 0; m < 4; ++m)
#pragma unroll
                    for (int n = 0; n < 2; ++n) acc[a][b][m][n] = (f32x4){0.f, 0.f, 0.f, 0.f};
        cur = nxt; cA = nA; cB = nB; ++ui;
        if (wr == 1) PG8_BAR;
    }
    PG8_WAIT_V(0);
    PG8_BAR;
#undef PG8_SA
#undef PG8_SB
#undef PG8_STAGE
#undef PG8_LDA
#undef PG8_LDB
#undef PG8_MMA
#undef PG8_WAIT_V
#undef PG8_WAIT_L
#undef PG8_BAR
#undef PG8_SCHED
}
}

struct Sched {
    int kind, G, c;
    const char* A0; const char* B0; char* O0; const float* R0;
    const char* A1; const char* B1; char* O1;
    int nM, nN, K;
    int r32;
    __device__ __forceinline__ static void order(int wgid, int nwg, int nM, int nN, int& pm, int& pn) {
        { const int q = nwg / 8, r = nwg % 8, xcd = wgid % 8, off = wgid / 8; wgid = (xcd < r ? xcd * (q + 1) : r * (q + 1) + (xcd - r) * q) + off; }
        const int nig = 8 * nN, gid = wgid / nig, fm = gid * 8, gsz = (nM - fm) < 8 ? (nM - fm) : 8;
        pm = fm + ((wgid % nig) % gsz); pn = (wgid % nig) / gsz;
    }
    __device__ __forceinline__ bool next(int i, pg8::Unit& u) const {
        const int L = i * G + c;
        if (kind == 0) {
            if (L < 512) { int pm, pn; order(L, 512, 32, 16, pm, pn);
                u.A = A0 + (size_t)pm * 256 * DM * 2; u.B = B0 + (size_t)pn * 256 * DM * 2; u.O = O0 + ((size_t)pm * 256 * ZW + pn * 256) * 2; u.R = nullptr; u.ldc = ZW; u.flag = (pn < 4) ? 1 : 0; return true; }
            const int L1 = L - 512; if (L1 >= 128) return false;
            int pm, pn; order(L1, 128, 4, 32, pm, pn);
            u.A = A1 + (size_t)pm * 256 * DM * 2; u.B = B1 + (size_t)pn * 256 * DM * 2;
            u.O = O1 + ((size_t)(pn >> 4) * 512 * 8192 + (size_t)(pm & 1) * 256 * 8192 + (size_t)(pm >> 1) * 4096 + (size_t)(pn & 15) * 256) * 2;
            u.R = nullptr; u.ldc = 8192; u.flag = 0; return true;
        } else if (kind == 2) {
            if (L >= 128) return false;
            const int xcd = L & 7, j = L >> 3, ks = xcd & 3, pm = (xcd >> 2) * 4 + (j & 3), pn = j >> 2;
            u.A = A0 + ((size_t)pm * 256 * 8192 + (size_t)ks * 2048) * 2; u.B = B0 + ((size_t)pn * 256 * 8192 + (size_t)ks * 2048) * 2;
            u.O = O0 + ((((size_t)ks * 2 + (pn >> 1)) * 2048 + (size_t)pm * 256) * 512 + (size_t)(pn & 1) * 256) * 2; u.R = nullptr; u.ldc = 512; u.flag = 0; return true;
        } else if (kind == 3) {
            if (L >= nM * nN) return false;
            int pm, pn; order(L, nM * nN, nM, nN, pm, pn);
            u.A = A0 + (size_t)pm * 256 * K * 2; u.B = B0 + (size_t)pn * 256 * K * 2; u.O = O0 + ((size_t)pm * 256 * DM + pn * 256) * 2; u.R = (const float*)((const char*)R0 + ((size_t)pm * 256 * DM + pn * 256) * (r32 ? 4 : 2)); u.ldc = DM; u.flag = r32; return true;
        } else if (kind == 5) {
            if (L >= 34 * 44) return false;
            int pm, pn; order(L, 34 * 44, 34, 44, pm, pn);
            const int b = pm / 17, j = pm % 17; const long row0 = (long)b * SEQ + 254 * j - 1;
            u.A = A0 + row0 * DM * 2; u.B = B0 + (size_t)pn * 128 * DM * 2; u.O = O0 + (row0 * DFF + pn * 128) * 2; u.R = R0 + pn * 128; u.ldc = DFF; u.flag = j; return true;
        } else {
            if (L >= nM * nN) return false;
            int pm, pn; order(L, nM * nN, nM, nN, pm, pn);
            u.A = A0 + (size_t)pm * 256 * K * 2; u.B = B0 + (size_t)pn * 256 * K * 2; u.O = O0 + ((size_t)pm * 256 * DFF2 + pn * 256) * 2; u.R = nullptr; u.ldc = DFF2; u.flag = 0; return true;
        }
    }
};


#define XB_TMO      128
#define XB_XCNT(j)  (256  + 64 * (j))
#define XB_XSUB(j)  (1280 + 64 * (j))
#define XB_XGEN(j)  (2304 + 64 * (j))
#define XB_TOP      3328
#define XB_TOPGEN   3392
#define XCD_BAR_WORDS 3456
#define XB_SPIN_CAP (1u << 22)
__device__ __forceinline__ unsigned xb_ld(unsigned* p)              { return __hip_atomic_load(p, __ATOMIC_RELAXED, __HIP_MEMORY_SCOPE_AGENT); }
__device__ __forceinline__ unsigned xb_add(unsigned* p, unsigned v) { return __hip_atomic_fetch_add(p, v, __ATOMIC_RELAXED, __HIP_MEMORY_SCOPE_AGENT); }
__device__ __forceinline__ unsigned xb_xcc_id() { return (unsigned)__builtin_amdgcn_s_getreg((3 << 11) | 20) & 0xFu; }
#define XB_SPIN(cond, bar) do { unsigned _sp = 0; while (cond) { __builtin_amdgcn_s_sleep(1); \
    if ((++_sp & 255u) == 0u) { if (xb_ld(&(bar)[XB_TMO])) break; if (_sp > XB_SPIN_CAP) { atomicAdd(&(bar)[XB_TMO], 1u); break; } } } } while (0)
struct XcdBarrier { unsigned* bar; unsigned x; volatile LAS unsigned* st; };
__device__ __forceinline__ XcdBarrier xcd_barrier_post(unsigned* bar, volatile LAS unsigned* st) {
    XcdBarrier b; b.bar = bar; b.x = xb_xcc_id(); b.st = st;
    if (threadIdx.x == 0) (void)xb_add(&bar[XB_XCNT(b.x)], 1u);
    return b;
}
__device__ __forceinline__ void xcd_barrier_complete(unsigned* bar, unsigned x, unsigned& nloc, unsigned& nx) {
    const unsigned G = gridDim.x * gridDim.y * gridDim.z;
    unsigned sum, cnt, mine, sp = 0u;
    for (;;) {
        sum = 0u; cnt = 0u; mine = 0u;
#pragma unroll
        for (unsigned j = 0; j < 16; ++j) { const unsigned c = xb_ld(&bar[XB_XCNT(j)]); sum += c; cnt += (c > 0u) ? 1u : 0u; mine = (j == x) ? c : mine; }
        if (sum == G) break;
        __builtin_amdgcn_s_sleep(1);
        if ((++sp & 255u) == 0u) { if (xb_ld(&bar[XB_TMO])) break; if (sp > XB_SPIN_CAP) { atomicAdd(&bar[XB_TMO], 1u); break; } }
    }
    nloc = mine > 0u ? mine : 1u; nx = cnt > 0u ? cnt : 1u;
}
__device__ __forceinline__ void xcd_barrier(const XcdBarrier& b) {
    asm volatile("s_waitcnt vmcnt(0)" ::: "memory");
    __syncthreads();
    if (threadIdx.x == 0) {
        unsigned* bar = b.bar;
        __builtin_amdgcn_s_waitcnt(0);
        unsigned nloc = b.st[0], nx = b.st[1];
        if (nloc == 0u) { xcd_barrier_complete(bar, b.x, nloc, nx); b.st[0] = nloc; b.st[1] = nx; }
        const unsigned old = xb_add(&bar[XB_XSUB(b.x)], 1u);
        const unsigned gen = old / nloc;
        if (old + 1u == (gen + 1u) * nloc) {
            __builtin_amdgcn_fence(__ATOMIC_RELEASE, "agent");
            asm volatile("s_waitcnt vmcnt(0)" ::: "memory");
            const unsigned og = xb_add(&bar[XB_TOP], 1u);
            const unsigned tg = og / nx;
            if (og + 1u == (tg + 1u) * nx) xb_add(&bar[XB_TOPGEN], 1u);
            else XB_SPIN(xb_ld(&bar[XB_TOPGEN]) == tg, bar);
            __builtin_amdgcn_fence(__ATOMIC_ACQUIRE, "agent");
            xb_add(&bar[XB_XGEN(b.x)], 1u);
            asm volatile("s_waitcnt vmcnt(0)" ::: "memory");
        } else {
            XB_SPIN(xb_ld(&bar[XB_XGEN(b.x)]) == gen, bar);
            __builtin_amdgcn_fence(__ATOMIC_ACQUIRE, "agent");
            asm volatile("s_waitcnt vmcnt(0)" ::: "memory");
        }
    }
    __syncthreads();
}

struct Params {
    const float* x; const float* w_in; const float* gmlp_ws; const float* gmlp_b; const float* fnet_w; const float* mix_gain; const float* w_out; const float* norm_mix;
    const float* norm_ffn; const float* ffn_up; const float* conv_w; const float* conv_b; const float* ffn_down; const float* rel_bias; const float* final_norm;
    float* out; unsigned char* ws; int ph_lo, ph_hi;
};

__device__ __forceinline__ void transpose_item(const float* W, int ldw, int K, bf16_t* WT, int nblk, LAS float* scr, int item, int lane) {
    const int kb = item / nblk, nb = item % nblk, k0 = 64 * kb, n0 = 64 * nb;
    f32x4 v[16];
#pragma unroll
    for (int i = 0; i < 16; ++i) v[i] = *(const f32x4*)(W + (size_t)(k0 + (lane >> 4) + 4 * i) * ldw + n0 + (lane & 15) * 4);
#pragma unroll
    for (int i = 0; i < 16; ++i) { LAS float* d = scr + ((lane >> 4) + 4 * i) * 65 + (lane & 15) * 4; d[0] = v[i][0]; d[1] = v[i][1]; d[2] = v[i][2]; d[3] = v[i][3]; }
    LDS_WAIT();
    const int c = lane & 7;
#pragma unroll
    for (int j = 0; j < 8; ++j) { const int n = (lane >> 3) + 8 * j; const LAS float* s = scr + (8 * c) * 65 + n;
        u32x4 o; o.x = pk2(s[0 * 65], s[1 * 65]); o.y = pk2(s[2 * 65], s[3 * 65]); o.z = pk2(s[4 * 65], s[5 * 65]); o.w = pk2(s[6 * 65], s[7 * 65]);
        *(u32x4*)(WT + (size_t)(n0 + n) * K + k0 + 8 * c) = o; }
    LDS_WAIT();
}

__device__ __forceinline__ int t5_bucket(int rel) {
    const int n = rel < 0 ? -rel : rel; int b;
    if (n < 8) b = n; else { const float v = logf((float)n / 8.0f) / logf(128.0f) * 8.0f; int lg = 8 + (int)v; b = lg < 15 ? lg : 15; }
    return b + (rel > 0 ? 16 : 0);
}

constexpr int TI_IN = (DM / 64) * (ZW / 64), TI_OUT = (DM / 64) * (DM / 64), TI_UP = (DM / 64) * (DFF2 / 64), TI_DN = (DFF / 64) * (DM / 64), TI_L = TI_IN + TI_OUT + TI_UP + TI_DN;
constexpr int TI_DEFER = 9472;
__device__ __forceinline__ void transpose_range(const Params& p, LAS unsigned char* lds, int l, int lo, int hi, int gw, int NGW, int wave, int lane) {
    unsigned char* ws = p.ws; LAS float* scr = (LAS float*)(lds + wave * 16640);
    for (int it = lo + gw; it < hi; it += NGW) {
        int r = it;
        if (r < TI_IN) { transpose_item(p.w_in + (size_t)l * DM * INW, INW, DM, (bf16_t*)(ws + WS_WIN + l * SZ_WIN), ZW / 64, scr, r, lane); continue; } r -= TI_IN;
        if (r < TI_OUT) { transpose_item(p.w_out + (size_t)l * DM * DM, DM, DM, (bf16_t*)(ws + WS_WOUT + l * SZ_WOUT), DM / 64, scr, r, lane); continue; } r -= TI_OUT;
        if (r < TI_UP) { transpose_item(p.ffn_up + (size_t)l * DM * DFF2, DFF2, DM, (bf16_t*)(ws + WS_WUP + l * SZ_WUP), DFF2 / 64, scr, r, lane); continue; } r -= TI_UP;
        transpose_item(p.ffn_down + (size_t)l * DFF * DM, DM, DFF, (bf16_t*)(ws + WS_WDN + l * SZ_WDN), DM / 64, scr, r, lane);
    }
}

__device__ __forceinline__ void phase_prep(const Params& p, LAS unsigned char* lds) {
    const int tid = opaque_tid(), lane = tid & 63, wave = tid >> 6; const int bid = opaque_bid();
    unsigned char* ws = p.ws;
    {
        const int gw = bid * NWAVES + wave, NGW = gridDim.x * NWAVES; const bool defer = (gridDim.x == 256);
        for (int l = 0; l < (defer ? 1 : DEPTH); ++l) transpose_range(p, lds, l, 0, defer ? TI_IN : TI_L, gw, NGW, wave, lane);
    }
    __syncthreads();
    {
        LAS float* ctab = (LAS float*)lds;
        LAS float* Mf = (LAS float*)(lds + 1024);
        if (tid < 64) ctab[tid] = cospif((float)tid * (1.0f / 32.0f));
        for (int grp = bid; grp < DEPTH * 2 * 8 * 4; grp += gridDim.x) {
            const int l = grp >> 6, part = (grp >> 5) & 1, g = (grp >> 2) & 7, kc4 = grp & 3;
            __syncthreads();
            const float* fw = p.fnet_w + ((size_t)l * 8 + g) * 64 * 64;
            LAS float* FW = (LAS float*)(lds + 1024 + 16384);
            { const f32x4 f0 = *(const f32x4*)(fw + tid * 8), f1 = *(const f32x4*)(fw + tid * 8 + 4); *(LAS f32x4*)(FW + tid * 8) = f0; *(LAS f32x4*)(FW + tid * 8 + 4) = f1; }
            __syncthreads();
            for (int idx = tid; idx < 4096; idx += NTHREADS) { const int c = idx >> 6, e = idx & 63; float a = 0.f;
#pragma unroll 8
                for (int m = 0; m < 64; ++m) { const int ti = (c * m - (part ? 16 : 0)) & 63; a += ctab[ti] * FW[m * 64 + e]; }
                Mf[idx] = a * (1.0f / 512.0f); }
            __syncthreads();
#pragma unroll 1
            for (int kci = 0; kci < 4; ++kci) { const int kc = kc4 * 4 + kci; asm volatile("" ::: "memory");
            const int k = kc * 128 + (tid & 127), eg = tid >> 7;
            const float* row = p.w_in + ((size_t)l * DM + k) * INW + ZW + g * 64;
            float a[16];
#pragma unroll
            for (int j = 0; j < 16; ++j) a[j] = 0.f;
            f32x4 rw[16];
#pragma unroll
            for (int c4 = 0; c4 < 16; ++c4) rw[c4] = *(const f32x4*)(row + 4 * c4);
#pragma unroll
            for (int c4 = 0; c4 < 16; ++c4)
#pragma unroll
                for (int cc = 0; cc < 4; ++cc) { const float wv = rw[c4][cc]; const LAS f32x4* mp = (const LAS f32x4*)(Mf + (4 * c4 + cc) * 64 + eg * 16);
#pragma unroll
                    for (int j4 = 0; j4 < 4; ++j4) { const f32x4 mv = mp[j4]; a[4 * j4 + 0] += wv * mv[0]; a[4 * j4 + 1] += wv * mv[1]; a[4 * j4 + 2] += wv * mv[2]; a[4 * j4 + 3] += wv * mv[3]; } }
            bf16_t* wt = (bf16_t*)(ws + WS_WF + l * SZ_WF);
#pragma unroll
            for (int j = 0; j < 16; ++j) wt[(size_t)(part * 512 + g * 64 + eg * 16 + j) * DM + k] = (bf16_t)f2bf(a[j]);
            }
        }
    }
    {
        bf16_t* dft = (bf16_t*)(ws + WS_DFT);
        LAS float* ct = (LAS float*)(lds + 65536);
        __syncthreads();
        for (int i = tid; i < 4096; i += NTHREADS) ct[i] = cospif((float)i * (1.0f / 2048.0f));
        __syncthreads();
        const int gt = bid * NTHREADS + tid, NGT = gridDim.x * NTHREADS;
        for (int it = gt; it < 2048 * 1024; it += NGT) {
            const int k = it >> 10, s0 = (it & 1023) * 8, part = s0 >> 12, sb = s0 & 4095, sh = part ? 1024 : 0;
            float v[8];
#pragma unroll
            for (int j = 0; j < 8; ++j) v[j] = ct[(k * (sb + j) - sh) & 4095];
            u32x4 o; o.x = pk2(v[0], v[1]); o.y = pk2(v[2], v[3]); o.z = pk2(v[4], v[5]); o.w = pk2(v[6], v[7]);
            *(u32x4*)(dft + (size_t)k * 8192 + s0) = o;
        }
        __syncthreads();
    }
    {
        float* tab = (float*)(ws + WS_TAB);
        const int gt = bid * NTHREADS + tid;
        if (gt < 16 * 3 * 129) { const int h = gt / 387, r = gt % 387, pp = r / 129, j = r % 129 - 64; const int d = pp == 0 ? 1 : (pp == 1 ? 4 : 16);
            tab[(h * 3 + pp) * 132 + j + 64] = p.rel_bias[t5_bucket(d * j) * 16 + h]; }
    }
}

template <bool OUT_F32, bool IN_BF16>
__device__ __forceinline__ void phase_rmsnorm(const void* Xv, const float* gain, void* out) {
    const float* X = (const float*)Xv; const bf16_t* Xb = (const bf16_t*)Xv;
    const int tid = opaque_tid(), lane = tid & 63, wave = tid >> 6; const int bid = opaque_bid();
    const int gw = bid * NWAVES + wave, NGW = gridDim.x * NWAVES;
    f32x4 g[4][2];
#pragma unroll
    for (int j = 0; j < 4; ++j) { g[j][0] = *(const f32x4*)(gain + 8 * lane + 512 * j); g[j][1] = *(const f32x4*)(gain + 8 * lane + 512 * j + 4); }
    constexpr int RPT = 4;
    for (int m0 = gw; m0 < NTOK; m0 += RPT * NGW) {
        f32x4 v[RPT][4][2]; u32x4 t[RPT][4];
#pragma unroll
        for (int r = 0; r < RPT; ++r) { const int mr = m0 + r * NGW, mc = mr < NTOK ? mr : m0;
#pragma unroll
            for (int j = 0; j < 4; ++j) { if (IN_BF16) t[r][j] = *(const u32x4*)(Xb + (size_t)mc * DM + 8 * lane + 512 * j);
                else { v[r][j][0] = *(const f32x4*)(X + (size_t)mc * DM + 8 * lane + 512 * j); v[r][j][1] = *(const f32x4*)(X + (size_t)mc * DM + 8 * lane + 512 * j + 4); } } }
        float rs[RPT];
#pragma unroll
        for (int r = 0; r < RPT; ++r) { float sq = 0.f;
#pragma unroll
            for (int j = 0; j < 4; ++j) { if (IN_BF16) { const u32x4 q = t[r][j]; v[r][j][0] = (f32x4){bflo(q.x), bfhi(q.x), bflo(q.y), bfhi(q.y)}; v[r][j][1] = (f32x4){bflo(q.z), bfhi(q.z), bflo(q.w), bfhi(q.w)}; }
#pragma unroll
                for (int h = 0; h < 2; ++h) { const f32x4 a = v[r][j][h]; sq += (a.x * a.x + a.y * a.y) + (a.z * a.z + a.w * a.w); } }
            rs[r] = 1.0f / sqrtf(wave_sum(sq) * (1.0f / DM) + EPS); }
#pragma unroll
        for (int r = 0; r < RPT; ++r) { const int m = m0 + r * NGW; if (m >= NTOK) continue;
#pragma unroll
            for (int j = 0; j < 4; ++j) { const f32x4 y0 = v[r][j][0] * rs[r] * g[j][0], y1 = v[r][j][1] * rs[r] * g[j][1];
                if (OUT_F32) { float* o = (float*)out + (size_t)m * DM + 8 * lane + 512 * j; *(f32x4*)o = y0; *(f32x4*)(o + 4) = y1; }
                else { u32x4 w; w.x = pk2(y0.x, y0.y); w.y = pk2(y0.z, y0.w); w.z = pk2(y1.x, y1.y); w.w = pk2(y1.z, y1.w); *(u32x4*)((bf16_t*)out + (size_t)m * DM + 8 * lane + 512 * j) = w; } } }
    }
}

constexpr int VROW = 144;
__device__ __forceinline__ s16x4 tr_read(const LAS unsigned char* p) { return __builtin_bit_cast(s16x4, __builtin_amdgcn_ds_read_tr16_b64_v4i16((LAS s16x4*)p)); }

__device__ __forceinline__ void phase_gmlp(const Params& p, int l, LAS unsigned char* lds) {
    const int tid = opaque_tid(), lane = tid & 63, wave = tid >> 6, fr = lane & 15, g = lane >> 4; const int bid = opaque_bid();
    const bf16_t* Z = (const bf16_t*)(p.ws + WS_Z); bf16_t* AO = (bf16_t*)(p.ws + WS_AO);
    const bool deal = (gridDim.x == 256);
    for (int ui = 0; ui < (deal ? (bid >= 128 ? 4 : 0) : (512 - bid + (int)gridDim.x - 1) / (int)gridDim.x); ++ui) { const int unit = deal ? (bid - 128) + 128 * ui : bid + ui * (int)gridDim.x; if (unit >= 512) break;
        const int h = unit & 7, ch = (unit >> 3) & 31, b = unit >> 8;
        const size_t row0 = (size_t)b * SEQ + ch * 128;
        u32x4 vch[2];
#pragma unroll
        for (int i = 0; i < 2; ++i) { const int cidx = tid + i * NTHREADS, r = cidx >> 3, c8 = cidx & 7; vch[i] = *(const u32x4*)(Z + (row0 + r) * ZW + 512 + h * 64 + c8 * 8); }
        const float* wsr = p.gmlp_ws + (((size_t)l * 8 + h) * 128 + wave * 16 + fr) * 128 + 8 * g;
        f32x4 a0[4], a1[4];
#pragma unroll
        for (int ks = 0; ks < 4; ++ks) { a0[ks] = *(const f32x4*)(wsr + 32 * ks); a1[ks] = *(const f32x4*)(wsr + 32 * ks + 4); }
        const f32x4 bias4 = *(const f32x4*)(p.gmlp_b + ((size_t)l * 8 + h) * 128 + wave * 16 + 4 * g);
        bf16_t uraw[4][4];
#pragma unroll
        for (int dt = 0; dt < 4; ++dt)
#pragma unroll
            for (int e = 0; e < 4; ++e) uraw[dt][e] = Z[(row0 + wave * 16 + 4 * g + e) * ZW + h * 64 + 16 * dt + fr];
        __syncthreads();
#pragma unroll
        for (int i = 0; i < 2; ++i) { const int cidx = tid + i * NTHREADS, r = cidx >> 3, c8 = cidx & 7; *(LAS u32x4*)(lds + r * VROW + c8 * 16) = vch[i]; }
        __syncthreads();
        bf16x8 af[4];
#pragma unroll
        for (int ks = 0; ks < 4; ++ks) { u32x4 w; w.x = pk2(a0[ks].x, a0[ks].y); w.y = pk2(a0[ks].z, a0[ks].w); w.z = pk2(a1[ks].x, a1[ks].y); w.w = pk2(a1[ks].z, a1[ks].w); af[ks] = __builtin_bit_cast(bf16x8, w); }
        const int q = (lane & 15) >> 2, pp = lane & 3;
#pragma unroll
        for (int dt = 0; dt < 4; ++dt) {
            f32x4 acc = (f32x4){0.f, 0.f, 0.f, 0.f};
#pragma unroll
            for (int ks = 0; ks < 4; ++ks) {
                const LAS unsigned char* base = lds + (32 * ks + 8 * g + q) * VROW + (16 * dt + 4 * pp) * 2;
                const s16x4 lo = tr_read(base), hi = tr_read(base + 4 * VROW);
                const bf16x8 bfr = (bf16x8){lo[0], lo[1], lo[2], lo[3], hi[0], hi[1], hi[2], hi[3]};
                acc = __builtin_amdgcn_mfma_f32_16x16x32_bf16(af[ks], bfr, acc, 0, 0, 0);
            }
#pragma unroll
            for (int e = 0; e < 4; ++e) { const size_t tok = row0 + wave * 16 + 4 * g + e; const int col = h * 64 + 16 * dt + fr;
                const float uu = bflo((unsigned)uraw[dt][e]);
                AO[tok * 512 + col] = (bf16_t)f2bf(uu * (acc[e] + bias4[e])); }
        }
    }
}

constexpr int ATT_TILE = 272 * VROW;
__device__ __forceinline__ void phase_attn(const Params& p, LAS unsigned char* lds) {
    const int tid = opaque_tid(), lane = tid & 63, wave = tid >> 6, qi = lane & 15, g = lane >> 4; const int bid = opaque_bid();
    const bf16_t* Z = (const bf16_t*)(p.ws + WS_Z); bf16_t* BO = (bf16_t*)(p.ws + WS_BO); float* LSE = (float*)(p.ws + WS_LSE);
    const float* TAB = (const float*)(p.ws + WS_TAB);
    LAS unsigned char* kl = lds; LAS unsigned char* vl = lds + ATT_TILE; LAS float* tabl = (LAS float*)(lds + 2 * ATT_TILE);
    constexpr float L2E = 1.4426950408889634f;
    constexpr int NJOB = 3072;
    __syncthreads();
    if (tid < 288) { const int which = tid / 144, off = tid % 144; unsigned z0; asm volatile("v_mov_b32 %0, 0" : "=v"(z0)); *(LAS u32x4*)(lds + which * ATT_TILE + 256 * VROW + off * 16) = (u32x4){z0, z0, z0, z0}; }
    u32x4 pre[8]; bf16x8 qpre[2]; float tabv = 0.f; unsigned okm = 0u;
#define ATT_DECODE(j, pp_, b_, h_, cls_, T_, lg_) do { pp_ = (j) >> 10; const int r_ = (j) & 1023, bh_ = r_ >> 5, rr_ = r_ & 31; lg_ = 2 * pp_; b_ = bh_ >> 4; h_ = bh_ & 15; cls_ = rr_ >> (5 - lg_); T_ = rr_ & ((32 >> lg_) - 1); } while (0)
#define ATT_PREFETCH(j) do { int pp_, b_, h_, cls_, T_, lg_; ATT_DECODE(j, pp_, b_, h_, cls_, T_, lg_); const bf16_t* Zb = Z + (size_t)b_ * SEQ * ZW + h_ * 64; const int Sd = SEQ >> lg_; okm = 0u; \
        _Pragma("unroll") for (int i = 0; i < 8; ++i) { const int idx = tid + 512 * (i & 3), row = idx >> 3, ch = idx & 7, u = 128 * T_ - 64 + row; const bool ok = (u >= 0) && (u < Sd); const int pos = cls_ + ((ok ? u : 0) << lg_); \
            okm |= ok ? (1u << i) : 0u; pre[i] = *(const u32x4*)(Zb + (size_t)pos * ZW + 2048 + (i >> 2) * 1024 + ch * 8); } \
        { const int qpos = cls_ + ((128 * T_ + 16 * wave + qi) << lg_); const bf16_t* qp = Zb + (size_t)qpos * ZW + 1024 + 16 * g; qpre[0] = *(const bf16x8*)qp; qpre[1] = *(const bf16x8*)(qp + 8); } \
        tabv = TAB[(h_ * 3 + pp_) * 132 + ((tid >= 16 && tid < 145) ? tid - 16 : 0)]; } while (0)
    const bool deal = (gridDim.x == 256);
    const int n_mine = deal ? (bid < 128 ? ATT_NA : 24 - ATT_NA) : (bid < NJOB ? (NJOB - bid + (int)gridDim.x - 1) / (int)gridDim.x : 0);
    const int vb = ((bid & 127) & 7) * 16 + ((bid & 127) >> 3);
#define ATT_JOB(idx) (deal ? (bid < 128 ? (idx) * 128 + vb : 128 * ATT_NA + (idx) * 128 + vb) : (bid + (idx) * (int)gridDim.x))
    if (n_mine > 0) ATT_PREFETCH(ATT_JOB(0));
    for (int jidx = 0; jidx < n_mine; ++jidx) { const int job = ATT_JOB(jidx);
        int pp, b, h, cls, T, lg; ATT_DECODE(job, pp, b, h, cls, T, lg);
        __syncthreads();
#pragma unroll
        for (int i = 0; i < 8; ++i) { const int idx = tid + 512 * (i & 3), row = idx >> 3, ch = idx & 7; *(LAS u32x4*)(lds + (i >> 2) * ATT_TILE + row * VROW + ch * 16) = ((okm >> i) & 1u) ? pre[i] : (u32x4){0u, 0u, 0u, 0u}; }
        if (tid < 160) tabl[tid] = (tid >= 16 && tid < 145) ? tabv * L2E : 0.f;
        const bf16x8 q0 = qpre[0], q1 = qpre[1];
        __syncthreads();
        if (jidx + 1 < n_mine) ATT_PREFETCH(ATT_JOB(jidx + 1));
        const int rowbase = 16 * wave, Sd = SEQ >> lg;
        f32x4 s[9];
        const LAS float* tb = tabl + (16 + 4 * g - qi);
        float tv[9][4];
        {
            bf16x8 kfr[9][2];
#define ATT_KLD(t) do { const LAS unsigned char* kp = kl + (rowbase + 16 * (t) + qi) * VROW + 32 * g; kfr[t][0] = *(const LAS bf16x8*)kp; kfr[t][1] = *(const LAS bf16x8*)(kp + 16); } while (0)
            ATT_KLD(0); ATT_KLD(1); ATT_KLD(2);
            __builtin_amdgcn_sched_barrier(0);
#pragma unroll
            for (int t = 0; t < 9; ++t) {
                if (t + 3 < 9) ATT_KLD(t + 3);
#pragma unroll
                for (int e = 0; e < 4; ++e) tv[t][e] = tb[16 * t + e];
                f32x4 a = (f32x4){0.f, 0.f, 0.f, 0.f};
                a = __builtin_amdgcn_mfma_f32_16x16x32_bf16(kfr[t][0], q0, a, 0, 0, 0); a = __builtin_amdgcn_mfma_f32_16x16x32_bf16(kfr[t][1], q1, a, 0, 0, 0); s[t] = a;
                __builtin_amdgcn_sched_barrier(0);
            }
#undef ATT_KLD
        }
        const int q4 = (lane & 15) >> 2, p4 = lane & 3;
        s16x4 vlo[2][4], vhi[2][4];
#define ATT_VLD(kb, slot) do { _Pragma("unroll") for (int dt = 0; dt < 4; ++dt) { const LAS unsigned char* base = vl + (rowbase + 32 * (kb) + 4 * g + q4) * VROW + (16 * p4 + 4 * dt) * 2; \
            vlo[slot][dt] = tr_read(base); vhi[slot][dt] = tr_read(base + 16 * VROW); } } while (0)
        ATT_VLD(0, 0);
        __builtin_amdgcn_sched_barrier(0);
        float mx = -1e30f;
        const int ukey0 = 128 * T - 64 + rowbase + 4 * g;
#pragma unroll
        for (int t = 0; t < 9; ++t)
#pragma unroll
            for (int e = 0; e < 4; ++e) {
                bool valid = (unsigned)(ukey0 + 16 * t + e) < (unsigned)Sd;
                if (t == 0) valid = valid && (4 * g + e >= qi);
                if (t == 8) valid = valid && (4 * g + e <= qi);
                const float xr = s[t][e] * (0.125f * L2E) + tv[t][e];
                const float xv = valid ? xr : -1e30f; s[t][e] = xv; mx = fmaxf(mx, xv); }
        mx = fmaxf(mx, __shfl_xor(mx, 16)); mx = fmaxf(mx, __shfl_xor(mx, 32));
        float lsum = 0.f;
#pragma unroll
        for (int t = 0; t < 9; ++t)
#pragma unroll
            for (int e = 0; e < 4; ++e) { const float pv = __builtin_amdgcn_exp2f(s[t][e] - mx); s[t][e] = pv; lsum += pv; }
        lsum += __shfl_xor(lsum, 16); lsum += __shfl_xor(lsum, 32);
        f32x4 o[4];
#pragma unroll
        for (int dt = 0; dt < 4; ++dt) o[dt] = (f32x4){0.f, 0.f, 0.f, 0.f};
        __builtin_amdgcn_sched_barrier(0);
#pragma unroll
        for (int kb = 0; kb < 5; ++kb) {
            if (kb + 1 < 5) ATT_VLD(kb + 1, (kb + 1) & 1);
            u32x4 pw; pw.x = pk2(s[2 * kb][0], s[2 * kb][1]); pw.y = pk2(s[2 * kb][2], s[2 * kb][3]);
            if (kb < 4) { pw.z = pk2(s[2 * kb + 1][0], s[2 * kb + 1][1]); pw.w = pk2(s[2 * kb + 1][2], s[2 * kb + 1][3]); } else { pw.z = 0u; pw.w = 0u; }
            const bf16x8 pf = __builtin_bit_cast(bf16x8, pw);
#pragma unroll
            for (int dt = 0; dt < 4; ++dt) {
                const s16x4 lo = vlo[kb & 1][dt], hi = vhi[kb & 1][dt];
                const bf16x8 vf = (bf16x8){lo[0], lo[1], lo[2], lo[3], hi[0], hi[1], hi[2], hi[3]};
                o[dt] = __builtin_amdgcn_mfma_f32_16x16x32_bf16(vf, pf, o[dt], 0, 0, 0);
            }
            __builtin_amdgcn_sched_barrier(0);
        }
#undef ATT_VLD
        const float inv = 1.0f / lsum;
        u32x4 w0, w1;
        w0.x = pk2(o[0][0] * inv, o[0][1] * inv); w0.y = pk2(o[0][2] * inv, o[0][3] * inv); w0.z = pk2(o[1][0] * inv, o[1][1] * inv); w0.w = pk2(o[1][2] * inv, o[1][3] * inv);
        w1.x = pk2(o[2][0] * inv, o[2][1] * inv); w1.y = pk2(o[2][2] * inv, o[2][3] * inv); w1.z = pk2(o[3][0] * inv, o[3][1] * inv); w1.w = pk2(o[3][2] * inv, o[3][3] * inv);
        const size_t tok = (size_t)b * SEQ + cls + ((128 * T + 16 * wave + qi) << lg);
        bf16_t* op = BO + ((size_t)pp * NTOK + tok) * 1024 + h * 64 + 16 * g;
        *(u32x4*)op = w0; *(u32x4*)(op + 8) = w1;
        if (g == 0) LSE[((size_t)pp * NTOK + tok) * 16 + h] = mx + __builtin_amdgcn_logf(lsum);
    }
#undef ATT_DECODE
#undef ATT_PREFETCH
#undef ATT_JOB
}

__device__ __forceinline__ void phase_r2048(const Params& p) {
    const int tid = opaque_tid(), lane = tid & 63, wave = tid >> 6; const int bid = opaque_bid();
    const bf16_t* T = (const bf16_t*)(p.ws + WS_T); float* R = (float*)(p.ws + WS_R2048);
    const bool deal = (gridDim.x == 256);
    const int gw = deal ? (bid - 128) * NWAVES + wave : bid * NWAVES + wave, NGW = deal ? 128 * NWAVES : (int)gridDim.x * NWAVES;
    if (deal && bid < 128) return;
    for (int job = gw; job < 1024; job += NGW) {
        const u32x4* tp = (const u32x4*)(T + (size_t)job * 8192) + lane; float acc = 0.f;
#pragma unroll
        for (int j = 0; j < 8; ++j) { float v[8]; unpack8(tp[64 * j], v); acc += ((v[0] - v[1]) + (v[2] - v[3])) + ((v[4] - v[5]) + (v[6] - v[7])); }
        acc = wave_sum(acc);
        if (lane == 0) R[job] = acc;
    }
}

__device__ __forceinline__ void phase_mixnorm(const Params& p, int l) {
    const int tid = opaque_tid(), lane = tid & 63, wave = tid >> 6; const int bid = opaque_bid();
    const int gw = bid * NWAVES + wave, NGW = gridDim.x * NWAVES;
    const bf16_t* __restrict__ AO = (const bf16_t*)(p.ws + WS_AO); const bf16_t* __restrict__ BO = (const bf16_t*)(p.ws + WS_BO); const float* __restrict__ CP = (const float*)(p.ws + WS_CP);
    bf16_t* __restrict__ MIX = (bf16_t*)(p.ws + WS_MIX);
    const float* __restrict__ gn = p.mix_gain + (size_t)l * DM;
#pragma unroll 4
    for (int m = gw; m < NTOK; m += NGW) {
        float a[8], bb[16], c[8];
        { const u32x4 w = *(const u32x4*)(AO + (size_t)m * 512 + lane * 8); a[0] = bflo(w.x); a[1] = bfhi(w.x); a[2] = bflo(w.y); a[3] = bfhi(w.y); a[4] = bflo(w.z); a[5] = bfhi(w.z); a[6] = bflo(w.w); a[7] = bfhi(w.w); }
        { const float* __restrict__ LSE = (const float*)(p.ws + WS_LSE); const int head = lane >> 2;
            const float l0 = LSE[((size_t)0 * NTOK + m) * 16 + head], l1 = LSE[((size_t)1 * NTOK + m) * 16 + head], l2 = LSE[((size_t)2 * NTOK + m) * 16 + head];
            const float lm = fmaxf(l0, fmaxf(l1, l2)); float wp[3] = {__builtin_amdgcn_exp2f(l0 - lm), __builtin_amdgcn_exp2f(l1 - lm), __builtin_amdgcn_exp2f(l2 - lm)};
            const float wi = 1.0f / (wp[0] + wp[1] + wp[2]);
#pragma unroll
            for (int j = 0; j < 16; ++j) bb[j] = 0.f;
#pragma unroll
            for (int pp = 0; pp < 3; ++pp) { const float wgt = wp[pp] * wi;
#pragma unroll
                for (int i = 0; i < 2; ++i) { const u32x4 w = *(const u32x4*)(BO + ((size_t)pp * NTOK + m) * 1024 + lane * 16 + i * 8); float t8[8]; unpack8(w, t8);
#pragma unroll
                    for (int j = 0; j < 8; ++j) bb[8 * i + j] += wgt * t8[j]; } } }
#pragma unroll
        for (int j = 0; j < 8; ++j) c[j] = 0.f;
        { const int b = m >> 12, k = m & 4095, kk = k < 2048 ? k : 4096 - k; const float sg = k < 2048 ? -1.0f : 1.0f;
          if (k == 2048) { const float* rp = (const float*)(p.ws + WS_R2048) + b * 512 + lane * 8; const f32x4 c0 = *(const f32x4*)rp, c1 = *(const f32x4*)(rp + 4);
              c[0] = c0.x; c[1] = c0.y; c[2] = c0.z; c[3] = c0.w; c[4] = c1.x; c[5] = c1.y; c[6] = c1.z; c[7] = c1.w; }
          else {
#pragma unroll
              for (int ks = 0; ks < 4; ++ks) { const bf16_t* cp = (const bf16_t*)CP + (((size_t)ks * 2 + b) * 2048 + kk) * 512 + lane * 8; float t8[8]; unpack8(*(const u32x4*)cp, t8); const float w = ks < 2 ? 1.0f : sg;
#pragma unroll
                  for (int j = 0; j < 8; ++j) c[j] += w * t8[j]; } } }
        float sa = 0.f, sb = 0.f, sc = 0.f;
#pragma unroll
        for (int j = 0; j < 8; ++j) { sa += a[j] * a[j]; sc += c[j] * c[j]; }
#pragma unroll
        for (int j = 0; j < 16; ++j) sb += bb[j] * bb[j];
        const float ra = 1.0f / sqrtf(wave_sum(sa) * (1.0f / 512.0f) + EPS), rb = 1.0f / sqrtf(wave_sum(sb) * (1.0f / 1024.0f) + EPS), rc = 1.0f / sqrtf(wave_sum(sc) * (1.0f / 512.0f) + EPS);
        bf16_t* o = MIX + (size_t)m * DM;
        { const float* gp = gn + lane * 8; u32x4 w; w.x = pk2(a[0] * ra * gp[0], a[1] * ra * gp[1]); w.y = pk2(a[2] * ra * gp[2], a[3] * ra * gp[3]); w.z = pk2(a[4] * ra * gp[4], a[5] * ra * gp[5]); w.w = pk2(a[6] * ra * gp[6], a[7] * ra * gp[7]);
            *(u32x4*)(o + lane * 8) = w; }
#pragma unroll
        for (int i = 0; i < 2; ++i) { const float* gp = gn + 512 + lane * 16 + i * 8; const float* v = bb + 8 * i; u32x4 w;
            w.x = pk2(v[0] * rb * gp[0], v[1] * rb * gp[1]); w.y = pk2(v[2] * rb * gp[2], v[3] * rb * gp[3]); w.z = pk2(v[4] * rb * gp[4], v[5] * rb * gp[5]); w.w = pk2(v[6] * rb * gp[6], v[7] * rb * gp[7]);
            *(u32x4*)(o + 512 + lane * 16 + i * 8) = w; }
        { const float* gp = gn + 1536 + lane * 8; u32x4 w; w.x = pk2(c[0] * rc * gp[0], c[1] * rc * gp[1]); w.y = pk2(c[2] * rc * gp[2], c[3] * rc * gp[3]); w.z = pk2(c[4] * rc * gp[4], c[5] * rc * gp[5]); w.w = pk2(c[6] * rc * gp[6], c[7] * rc * gp[7]);
            *(u32x4*)(o + 1536 + lane * 8) = w; }
    }
}

__device__ __forceinline__ void phase_convgate(const Params& p, int l) {
    const int tid = opaque_tid(), lane = tid & 63, wave = tid >> 6; const int bid = opaque_bid();
    const int gw = bid * NWAVES + wave, NGW = gridDim.x * NWAVES;
    const bf16_t* H = (const bf16_t*)(p.ws + WS_H); bf16_t* ACT = (bf16_t*)(p.ws + WS_ACT);
    const float* cw = p.conv_w + (size_t)l * 3 * DFF2; const float* cb = p.conv_b + (size_t)l * DFF2;
    for (int it = gw; it < 11 * 1024; it += NGW) {
        const int cc = it % 11, strip = it / 11, col = cc * 512 + lane * 8, t0 = strip * 8;
        u32x4 gr[10], ur[10];
#pragma unroll
        for (int i = 0; i < 10; ++i) { int t = t0 - 1 + i; t = t < 0 ? 0 : (t > NTOK - 1 ? NTOK - 1 : t);
            gr[i] = *(const u32x4*)(H + (size_t)t * DFF2 + col); ur[i] = *(const u32x4*)(H + (size_t)t * DFF2 + DFF + col); }
        float wg[3][8], wu[3][8], bg[8], bu[8];
#pragma unroll
        for (int k = 0; k < 3; ++k) { const f32x4 a0 = *(const f32x4*)(cw + k * DFF2 + col), a1 = *(const f32x4*)(cw + k * DFF2 + col + 4), b0 = *(const f32x4*)(cw + k * DFF2 + DFF + col), b1 = *(const f32x4*)(cw + k * DFF2 + DFF + col + 4);
#pragma unroll
            for (int j = 0; j < 4; ++j) { wg[k][j] = a0[j]; wg[k][4 + j] = a1[j]; wu[k][j] = b0[j]; wu[k][4 + j] = b1[j]; } }
        { const f32x4 a0 = *(const f32x4*)(cb + col), a1 = *(const f32x4*)(cb + col + 4), b0 = *(const f32x4*)(cb + DFF + col), b1 = *(const f32x4*)(cb + DFF + col + 4);
#pragma unroll
            for (int j = 0; j < 4; ++j) { bg[j] = a0[j]; bg[4 + j] = a1[j]; bu[j] = b0[j]; bu[4 + j] = b1[j]; } }
        const bool first = (t0 & (SEQ - 1)) == 0, lastr = ((t0 + 8) & (SEQ - 1)) == 0;
        float gp[8], gc[8], gn[8], up[8], uc[8], un[8];
        unpack8(gr[0], gp); unpack8(ur[0], up); unpack8(gr[1], gc); unpack8(ur[1], uc);
        if (first) {
#pragma unroll
            for (int j = 0; j < 8; ++j) { gp[j] = 0.f; up[j] = 0.f; } }
#pragma unroll
        for (int i = 0; i < 8; ++i) {
            unpack8(gr[i + 2], gn); unpack8(ur[i + 2], un);
            if (i == 7 && lastr) {
#pragma unroll
                for (int j = 0; j < 8; ++j) { gn[j] = 0.f; un[j] = 0.f; } }
            float r[8];
#pragma unroll
            for (int j = 0; j < 8; ++j) { const float G = gp[j] * wg[0][j] + gc[j] * wg[1][j] + gn[j] * wg[2][j] + bg[j]; const float U = up[j] * wu[0][j] + uc[j] * wu[1][j] + un[j] * wu[2][j] + bu[j];
                r[j] = G * __builtin_amdgcn_rcpf(1.0f + __expf(-G)) * U; gp[j] = gc[j]; gc[j] = gn[j]; up[j] = uc[j]; uc[j] = un[j]; }
            u32x4 w; w.x = pk2(r[0], r[1]); w.y = pk2(r[2], r[3]); w.z = pk2(r[4], r[5]); w.w = pk2(r[6], r[7]);
            *(u32x4*)(ACT + (size_t)(t0 + i) * DFF + col) = w;
        }
    }
}

constexpr int NPHASE = 2 + 8 * DEPTH;
__global__ void __launch_bounds__(NTHREADS) fwd_megakernel(Params p) {
    extern __shared__ __attribute__((aligned(16))) unsigned char lds_raw[];
    LAS unsigned char* lds = (LAS unsigned char*)lds_raw;
    unsigned char* ws = p.ws;
    bf16_t* XB = (bf16_t*)(ws + WS_X);
    volatile LAS unsigned* bst = (volatile LAS unsigned*)(lds + 143360);
    if (threadIdx.x < 2) bst[threadIdx.x] = 0u;
    __syncthreads();
    const XcdBarrier gbar = xcd_barrier_post((unsigned*)(ws + WS_CTL), bst);
    for (int ph = p.ph_lo; ph < p.ph_hi; ++ph) {
        bool need_bar = true;
        if (ph == 0) { phase_prep(p, lds); phase_rmsnorm<false, false>(p.x, p.norm_mix, ws + WS_XN); }
        else if (ph == NPHASE - 1) phase_rmsnorm<true, true>(XB, p.final_norm, p.out);
        else {
            const int l = (ph - 1) / 8, k = (ph - 1) % 8;
            Sched S; S.G = gridDim.x; S.c = opaque_bid(); S.kind = -1; S.A0 = S.B0 = S.A1 = S.B1 = nullptr; S.O0 = S.O1 = nullptr; S.R0 = nullptr; S.r32 = 0; S.nM = S.nN = 0; S.K = DM;
            int gK = DM, lda = DM, ldb = DM; int epi = 0;
            if (k == 0) { if (l > 0) phase_rmsnorm<false, true>(XB, p.norm_mix + (size_t)l * DM, ws + WS_XN); else need_bar = false; }
            else if (k == 1) { S.kind = 0; S.A0 = (const char*)(ws + WS_XN); S.B0 = (const char*)(ws + WS_WIN + l * SZ_WIN); S.O0 = (char*)(ws + WS_Z);
                S.A1 = (const char*)(ws + WS_WF + l * SZ_WF); S.B1 = (const char*)(ws + WS_XN); S.O1 = (char*)(ws + WS_T); }
            else if (k == 2) { S.kind = 2; S.A0 = (const char*)(ws + WS_DFT); S.B0 = (const char*)(ws + WS_T); S.O0 = (char*)(ws + WS_CP); lda = 8192; ldb = 8192; epi = 0; }
            else if (k == 3) phase_mixnorm(p, l);
            else if (k == 4) { S.kind = 3; S.A0 = (const char*)(ws + WS_MIX); S.B0 = (const char*)(ws + WS_WOUT + l * SZ_WOUT); S.O0 = (char*)XB; S.R0 = (l == 0) ? p.x : (const float*)XB; S.r32 = (l == 0) ? 1 : 0; S.nM = 32; S.nN = 8; epi = 1; }
            else if (k == 5) phase_rmsnorm<false, true>(XB, p.norm_ffn + (size_t)l * DM, ws + WS_XN);
            else if (k == 6) { S.kind = 5; S.A0 = (const char*)(ws + WS_XN); S.B0 = (const char*)(ws + WS_WUP + l * SZ_WUP); S.O0 = (char*)(ws + WS_ACT); S.R0 = p.conv_w + (size_t)l * 3 * DFF2; epi = 2; }
            else { S.kind = 3; S.A0 = (const char*)(ws + WS_ACT); S.B0 = (const char*)(ws + WS_WDN + l * SZ_WDN); S.O0 = (char*)XB; S.R0 = (const float*)XB; S.r32 = 0; S.nM = 32; S.nN = 8; S.K = DFF; gK = DFF; lda = DFF; ldb = DFF; epi = 1; }
            if (S.kind >= 0) {
                if (epi == 0) pg8::gemm_phase<pg8::EpiBf16, Sched>(lds, gK, lda, ldb, S, pg8::EpiBf16{});
                else if (epi == 1) pg8::gemm_phase<pg8::EpiF32, Sched>(lds, gK, lda, ldb, S, pg8::EpiF32{});
                else pg8::gemm_phase<pg8::EpiConvGate, Sched>(lds, gK, lda, ldb, S, pg8::EpiConvGate{p.conv_w + (size_t)l * 3 * DFF2, p.conv_b + (size_t)l * DFF2, (LAS float*)(lds + 131072)}, DFF);
            }
            if (k == 1 && gridDim.x == 256 && S.c >= 128) { __syncthreads(); const int t_ = opaque_tid(); const int gw_ = (S.c - 128) * NWAVES + (t_ >> 6);
                transpose_range(p, lds, l, TI_IN, TI_IN + TI_OUT + TI_UP, gw_, 128 * NWAVES, t_ >> 6, t_ & 63);
                if (l + 1 < DEPTH) transpose_range(p, lds, l + 1, 0, TI_IN, gw_, 128 * NWAVES, t_ >> 6, t_ & 63); }
            if (k == 6 && gridDim.x == 256 && S.c >= 216) { __syncthreads(); const int t_ = opaque_tid();
                transpose_range(p, lds, l, TI_IN + TI_OUT + TI_UP, TI_L, (S.c - 216) * NWAVES + (t_ >> 6), 40 * NWAVES, t_ >> 6, t_ & 63); }
            if (k == 2) { __syncthreads(); phase_attn(p, lds); __syncthreads(); phase_gmlp(p, l, lds); phase_r2048(p); }
        }
        if (ph + 1 < p.ph_hi && need_bar) { if (p.ph_lo < 0) cg::this_grid().sync(); else xcd_barrier(gbar); }
    }
}

extern "C" void kernel_launch(void* const* d_in, const int* in_sizes, int n_in, void* d_out, int out_size, void* d_ws, size_t ws_size, hipStream_t stream) {
    static int grid = 0;
    if (grid == 0) {
        if (n_in != 15 || in_sizes[0] != NTOK * DM || out_size != NTOK * DM || ws_size < WS_END) { fprintf(stderr, "kernel_launch: unexpected shapes / workspace (%d inputs, in0 %d, out %d, ws %zu < %zu)\n", n_in, n_in > 0 ? in_sizes[0] : -1, out_size, ws_size, (size_t)WS_END); grid = -1; return; }
        int dev = 0, cus = 0, per_cu = 0;
        hipGetDevice(&dev); hipDeviceGetAttribute(&cus, hipDeviceAttributeMultiprocessorCount, dev);
        if (hipFuncSetAttribute((const void*)fwd_megakernel, hipFuncAttributeMaxDynamicSharedMemorySize, LDS_BYTES) != hipSuccess) { fprintf(stderr, "kernel_launch: hipFuncSetAttribute failed\n"); grid = -1; return; }
        if (hipOccupancyMaxActiveBlocksPerMultiprocessor(&per_cu, (const void*)fwd_megakernel, NTHREADS, LDS_BYTES) != hipSuccess || per_cu < 1) { fprintf(stderr, "kernel_launch: occupancy query says %d\n", per_cu); per_cu = 1; }
        (void)hipGetLastError();
        grid = cus * 1;
        if (grid <= 0) grid = 256;
    }
    if (grid < 0) return;
    if (hipMemsetAsync((unsigned char*)d_ws + WS_CTL, 0, CTL_BYTES, stream) != hipSuccess) { fprintf(stderr, "kernel_launch: memset failed\n"); return; }
    Params p{};
    p.x = (const float*)d_in[0]; p.w_in = (const float*)d_in[1]; p.gmlp_ws = (const float*)d_in[2]; p.gmlp_b = (const float*)d_in[3]; p.fnet_w = (const float*)d_in[4];
    p.mix_gain = (const float*)d_in[5]; p.w_out = (const float*)d_in[6]; p.norm_mix = (const float*)d_in[7]; p.norm_ffn = (const float*)d_in[8]; p.ffn_up = (const float*)d_in[9];
    p.conv_w = (const float*)d_in[10]; p.conv_b = (const float*)d_in[11]; p.ffn_down = (const float*)d_in[12]; p.rel_bias = (const float*)d_in[13]; p.final_norm = (const float*)d_in[14];
    p.out = (float*)d_out; p.ws = (unsigned char*)d_ws;
#if MK_PER_PHASE_LAUNCH
    for (int ph = 0; ph < NPHASE; ++ph) { p.ph_lo = ph; p.ph_hi = ph + 1; hipLaunchKernelGGL(fwd_megakernel, dim3(grid), dim3(NTHREADS), LDS_BYTES, stream, p); }
#else
    p.ph_lo = 0; p.ph_hi = NPHASE;
    void* args[] = {&p};
    hipError_t e = hipLaunchCooperativeKernel((const void*)fwd_megakernel, dim3(grid), dim3(NTHREADS), args, LDS_BYTES, stream);
    if (e != hipSuccess) fprintf(stderr, "kernel_launch: cooperative launch failed: %s (grid %d)\n", hipGetErrorString(e), grid);
#endif
}
```
